# Optimizing an MI355X kernel written in HIP

```python
import math
import jax
import jax.numpy as jnp
from jax import lax
import numpy as np


D_MODEL = 1024
BATCH = 16
SEQ = 4096
DEPTH = 2

MEM_LEN = 256
RMS_EPS = 1e-6
ROPE_THETA = 10000.0
NEG_INF = -1e30
FORCE_BONUS = 1e3

NSA_HEADS = 8
NSA_KV_GROUPS = 2
NSA_HPG = NSA_HEADS // NSA_KV_GROUPS
NSA_HD = 64
CMP_LEN = 32
CMP_STRIDE = 16
CMP_HID = 2 * NSA_HD
SLC_BLK = 64
SLC_TOPK = 16
WINDOW = 512
NSA_QBLK = 32

GDN_HEADS = 8
GDN_HD = 64
GDN_CONV = 4
GDN_CHUNK = 64

SC_WIDTH = 3

XA_HEADS = 4
XA_HD = 128

D_FF = 4 * D_MODEL

NSA_WIDTH = NSA_HEADS * NSA_HD
NSA_KV_WIDTH = NSA_KV_GROUPS * NSA_HD
GDN_WIDTH = GDN_HEADS * GDN_HD
MIX_WIDTH = NSA_WIDTH + GDN_WIDTH
XA_WIDTH = XA_HEADS * XA_HD
IN_SIZES = (NSA_WIDTH, NSA_KV_WIDTH, NSA_KV_WIDTH, NSA_KV_WIDTH, NSA_KV_WIDTH, NSA_KV_WIDTH, NSA_KV_WIDTH, 3 * NSA_HEADS, GDN_WIDTH, GDN_WIDTH, GDN_WIDTH, GDN_HEADS, GDN_HEADS, GDN_WIDTH)
IN_COLS = sum(IN_SIZES)
N_HYB = (DEPTH + 1) // 2
N_SC = DEPTH // 2

kernel_name = 'hybrid_nsa_gdn_shortconv_decoder'


def rms_norm(x, w):
    xf = x.astype(jnp.float32)
    y = xf * lax.rsqrt(jnp.mean(xf * xf, axis=-1, keepdims=True) + RMS_EPS)
    return (y * w.astype(jnp.float32)).astype(x.dtype)


def l2_norm(x):
    xf = x.astype(jnp.float32)
    return xf * lax.rsqrt(jnp.sum(xf * xf, axis=-1, keepdims=True) + 1e-6)


def rope(x, positions):
    d = x.shape[-1]
    inv_freq = ROPE_THETA ** (-jnp.arange(0, d, 2, dtype=jnp.float32) / d)
    ang = positions.astype(jnp.float32)[..., None] * inv_freq
    cos = jnp.cos(ang)[:, :, None, :]
    sin = jnp.sin(ang)[:, :, None, :]
    xf = x.astype(jnp.float32)
    x1, x2 = xf[..., : d // 2], xf[..., d // 2:]
    return jnp.concatenate([x1 * cos - x2 * sin, x2 * cos + x1 * sin], axis=-1).astype(x.dtype)


def causal_dwconv(x, w):
    k_len, ch = w.shape
    return lax.conv_general_dilated(x, w[:, None, :].astype(x.dtype), window_strides=(1,), padding=[(k_len - 1, 0)], dimension_numbers=('NWC', 'WIO', 'NWC'), feature_group_count=ch)


def compress_blocks(t, pos_emb, w1, w2):
    b_, s_, g_, d = t.shape
    n_cmp = (s_ - CMP_LEN) // CMP_STRIDE + 1
    idx = np.arange(n_cmp)[:, None] * CMP_STRIDE + np.arange(CMP_LEN)[None, :]
    blocks = t[:, idx] + pos_emb[None, None, :, None, :]
    flat = blocks.transpose(0, 3, 1, 2, 4).reshape(b_, g_, n_cmp, CMP_LEN * d)
    return jax.nn.silu(flat @ w1) @ w2


def cmp_to_slc_matrix(n_cmp, n_slc):
    cs = np.arange(n_cmp)[:, None] * CMP_STRIDE
    js = np.arange(n_slc)[None, :] * SLC_BLK
    ov = np.clip(np.minimum(cs + CMP_LEN, js + SLC_BLK) - np.maximum(cs, js), 0, None)
    return jnp.asarray(ov / CMP_LEN, dtype=jnp.float32)


def nsa_attention(q, k_cmp, v_cmp, k_slc, v_slc, k_win, v_win, gates, ck_pos, ck_w1, ck_w2, cv_pos, cv_w1, cv_w2):
    b_, s_ = q.shape[:2]
    g_, hpg, d = NSA_KV_GROUPS, NSA_HPG, NSA_HD
    scale = d ** -0.5
    kc = compress_blocks(k_cmp, ck_pos, ck_w1, ck_w2)
    vc = compress_blocks(v_cmp, cv_pos, cv_w1, cv_w2)
    n_cmp = kc.shape[2]
    cmp_end = jnp.arange(n_cmp) * CMP_STRIDE + CMP_LEN - 1
    n_slc = s_ // SLC_BLK
    n_sel = min(SLC_TOPK, n_slc)
    overlap = cmp_to_slc_matrix(n_cmp, n_slc)
    ks_blk = k_slc.reshape(b_, n_slc, SLC_BLK, g_, d).transpose(0, 3, 1, 2, 4)
    vs_blk = v_slc.reshape(b_, n_slc, SLC_BLK, g_, d).transpose(0, 3, 1, 2, 4)
    kw = jnp.pad(k_win, ((0, 0), (WINDOW, 0), (0, 0), (0, 0))).transpose(0, 2, 1, 3)
    vw = jnp.pad(v_win, ((0, 0), (WINDOW, 0), (0, 0), (0, 0))).transpose(0, 2, 1, 3)
    n_qb = s_ // NSA_QBLK
    qb = q.reshape(b_, n_qb, NSA_QBLK, g_, hpg, d).transpose(1, 0, 3, 4, 2, 5)
    gb = gates.reshape(b_, n_qb, NSA_QBLK, g_, hpg, 3).transpose(1, 0, 3, 4, 2, 5)
    b_ix = jnp.arange(b_)[:, None, None, None]
    g_ix = jnp.arange(g_)[None, :, None, None]
    slc_j = jnp.arange(n_slc)

    def query_block(args):
        qc, gc, c = args
        t = c * NSA_QBLK + jnp.arange(NSA_QBLK)
        s = jnp.einsum('bghqd,bgnd->bghqn', qc, kc).astype(jnp.float32) * scale
        valid = cmp_end[None, :] <= t[:, None]
        p_cmp = jax.nn.softmax(jnp.where(valid, s, NEG_INF), axis=-1) * valid
        o_cmp = jnp.einsum('bghqn,bgnd->bghqd', p_cmp.astype(vc.dtype), vc)
        imp = jnp.einsum('bghqn,nj->bgqj', p_cmp, overlap)
        cur = t // SLC_BLK
        forced = (slc_j[None, :] == 0) | (slc_j[None, :] == cur[:, None]) | (slc_j[None, :] == cur[:, None] - 1)
        causal_blk = slc_j[None, :] * SLC_BLK <= t[:, None]
        imp = jnp.where(causal_blk, jnp.where(forced, imp + FORCE_BONUS, imp), -1.0)
        _, sel = lax.top_k(imp, n_sel)
        kg = ks_blk[b_ix, g_ix, sel]
        vg = vs_blk[b_ix, g_ix, sel]
        tok = sel[..., None] * SLC_BLK + jnp.arange(SLC_BLK)
        tok_ok = tok <= t[None, None, :, None, None]
        s = jnp.einsum('bghqd,bgqnld->bghqnl', qc, kg).astype(jnp.float32) * scale
        s = jnp.where(tok_ok[:, :, None], s, NEG_INF).reshape(b_, g_, hpg, NSA_QBLK, n_sel * SLC_BLK)
        p = jax.nn.softmax(s, axis=-1).reshape(b_, g_, hpg, NSA_QBLK, n_sel, SLC_BLK)
        o_slc = jnp.einsum('bghqnl,bgqnld->bghqd', p.astype(vg.dtype), vg)
        kwc = lax.dynamic_slice_in_dim(kw, c * NSA_QBLK, NSA_QBLK + WINDOW, axis=2)
        vwc = lax.dynamic_slice_in_dim(vw, c * NSA_QBLK, NSA_QBLK + WINDOW, axis=2)
        kpos = c * NSA_QBLK - WINDOW + jnp.arange(NSA_QBLK + WINDOW)
        win_ok = (kpos[None, :] <= t[:, None]) & (kpos[None, :] > t[:, None] - WINDOW) & (kpos[None, :] >= 0)
        s = jnp.einsum('bghqd,bgkd->bghqk', qc, kwc).astype(jnp.float32) * scale
        p = jax.nn.softmax(jnp.where(win_ok, s, NEG_INF), axis=-1)
        o_win = jnp.einsum('bghqk,bgkd->bghqd', p.astype(vwc.dtype), vwc)
        return gc[..., 0:1] * o_cmp + gc[..., 1:2] * o_slc + gc[..., 2:3] * o_win

    o = lax.map(query_block, (qb, gb, jnp.arange(n_qb)))
    return o.transpose(1, 0, 4, 2, 3, 5).reshape(b_, s_, NSA_HEADS * d)


def chunk_gated_delta_rule(q, k, v, g, beta):
    b_, s_, h_, dk = q.shape
    dv = v.shape[-1]
    c_len = GDN_CHUNK
    n_ch = s_ // c_len

    def to_chunks(t):
        t = t.reshape(b_, n_ch, c_len, h_, *t.shape[3:])
        return jnp.moveaxis(t, (1, 3), (0, 2))

    qc, kc, vc, bc = to_chunks(q), to_chunks(k), to_chunks(v), to_chunks(beta)
    gcs = jnp.cumsum(to_chunks(g), axis=-1)
    incl = jnp.tril(jnp.ones((c_len, c_len), dtype=bool))
    strict = jnp.tril(jnp.ones((c_len, c_len), dtype=bool), -1)
    decay = jnp.exp(jnp.where(incl, gcs[..., :, None] - gcs[..., None, :], NEG_INF))
    kb = kc * bc[..., None]
    a_mat = jnp.where(strict, jnp.einsum('nbhcd,nbhed->nbhce', kb, kc) * decay, 0.0)
    eye = jnp.eye(c_len, dtype=jnp.float32)
    t_inv = lax.linalg.triangular_solve(eye + a_mat, jnp.broadcast_to(eye, a_mat.shape), left_side=True, lower=True, unit_diagonal=True)
    u = t_inv @ (vc * bc[..., None])
    w = t_inv @ (kb * jnp.exp(gcs)[..., None])
    qk = jnp.einsum('nbhcd,nbhed->nbhce', qc, kc) * decay

    def step(state, xs):
        q_i, k_i, u_i, w_i, qk_i, g_i = xs
        v_new = u_i - w_i @ state
        o_i = (q_i * jnp.exp(g_i)[..., None]) @ state + qk_i @ v_new
        g_last = g_i[..., -1:]
        state = state * jnp.exp(g_last)[..., None] + jnp.einsum('bhcd,bhce->bhde', k_i * jnp.exp(g_last - g_i)[..., None], v_new)
        return state, o_i

    state0 = jnp.zeros((b_, h_, dk, dv), jnp.float32)
    _, o = lax.scan(step, state0, (qc, kc, u, w, qk, gcs))
    return jnp.moveaxis(o, (0, 2), (1, 3)).reshape(b_, s_, h_, dv)


def gated_deltanet(q, k, v, a, b, z, conv_w, a_log, dt_bias, norm_w):
    b_, s_ = q.shape[:2]
    h_, d = GDN_HEADS, GDN_HD
    qkv = jax.nn.silu(causal_dwconv(jnp.concatenate([q, k, v], axis=-1), conv_w))
    q, k, v = jnp.split(qkv, 3, axis=-1)
    q = l2_norm(q.reshape(b_, s_, h_, d)) * (d ** -0.5)
    k = l2_norm(k.reshape(b_, s_, h_, d))
    v = v.reshape(b_, s_, h_, d).astype(jnp.float32)
    beta = jax.nn.sigmoid(b.astype(jnp.float32))
    g = -jnp.exp(a_log.astype(jnp.float32)) * jax.nn.softplus(a.astype(jnp.float32) + dt_bias.astype(jnp.float32))
    o = chunk_gated_delta_rule(q, k, v, g, beta)
    o = rms_norm(o, norm_w) * jax.nn.silu(z.reshape(b_, s_, h_, d).astype(jnp.float32))
    return o.reshape(b_, s_, h_ * d).astype(z.dtype)


def hybrid_mixer(h, positions, w_in, ck_pos, ck_w1, ck_w2, cv_pos, cv_w1, cv_w2, gdn_conv, gdn_a_log, gdn_dt_bias, gdn_norm, w_out):
    b_, s_, _ = h.shape
    splits = [int(p) for p in np.cumsum(IN_SIZES)[:-1]]
    (nq, kcmp, vcmp, kslc, vslc, kwin, vwin, ngate, gq, gk, gv, ga, gb, gz) = jnp.split(h @ w_in, splits, axis=-1)

    def heads(t, n):
        return t.reshape(b_, s_, n, -1)

    g_ = NSA_KV_GROUPS
    o_nsa = nsa_attention(rope(heads(nq, NSA_HEADS), positions), heads(kcmp, g_), heads(vcmp, g_), rope(heads(kslc, g_), positions), heads(vslc, g_), rope(heads(kwin, g_), positions), heads(vwin, g_), jax.nn.sigmoid(ngate).reshape(b_, s_, NSA_HEADS, 3), ck_pos, ck_w1, ck_w2, cv_pos, cv_w1, cv_w2)
    o_gdn = gated_deltanet(gq, gk, gv, ga, gb, gz, gdn_conv, gdn_a_log, gdn_dt_bias, gdn_norm)
    return jnp.concatenate([o_nsa, o_gdn], axis=-1) @ w_out


def short_conv_mixer(h, w_in, conv_w, w_out):
    b_gate, c_gate, u = jnp.split(h @ w_in, 3, axis=-1)
    return (b_gate * causal_dwconv(c_gate * u, conv_w)) @ w_out


def cross_attention(h, mem_n, wq, wkv, wo):
    b_, s_, _ = h.shape
    q = (h @ wq).reshape(b_, s_, XA_HEADS, XA_HD)
    k, v = jnp.split(mem_n @ wkv, 2, axis=-1)
    k = k.reshape(b_, -1, XA_HEADS, XA_HD)
    v = v.reshape(b_, -1, XA_HEADS, XA_HD)
    s = jnp.einsum('bshd,bmhd->bhsm', q, k).astype(jnp.float32) * (XA_HD ** -0.5)
    p = jax.nn.softmax(s, axis=-1).astype(v.dtype)
    o = jnp.einsum('bhsm,bmhd->bshd', p, v).reshape(b_, s_, XA_WIDTH)
    return o @ wo


def squared_relu_mlp(h, w1, w2):
    return jnp.square(jax.nn.relu(h @ w1)) @ w2


def setup_inputs(seed: int = 0) -> dict:
    key = jax.random.key(seed)
    ks = list(jax.random.split(key, 32))
    f32 = jnp.float32

    def dense(shape, fan_in, gain=1.0):
        return jax.random.normal(ks.pop(), shape, f32) * (gain * fan_in ** -0.5)

    def norm_gain(shape):
        return 1.0 + 0.05 * jax.random.normal(ks.pop(), shape, f32)

    x = jax.random.normal(ks.pop(), (BATCH, SEQ, D_MODEL), f32)
    mem = jax.random.normal(ks.pop(), (BATCH, MEM_LEN, D_MODEL), f32)
    offs = jax.random.randint(ks.pop(), (BATCH, 1), 0, 1024, dtype=jnp.int32)
    positions = offs + jnp.arange(SEQ, dtype=jnp.int32)[None, :]
    dt = jnp.exp(jax.random.uniform(ks.pop(), (N_HYB, GDN_HEADS), f32, math.log(1e-3), math.log(1e-1)))
    return {
        'x': x,
        'mem': mem,
        'positions': positions,
        'norm_mix': norm_gain((DEPTH, D_MODEL)),
        'norm_xattn': norm_gain((DEPTH, D_MODEL)),
        'norm_mlp': norm_gain((DEPTH, D_MODEL)),
        'hyb_w_in': dense((N_HYB, D_MODEL, IN_COLS), D_MODEL),
        'hyb_cmp_k_pos': 0.02 * jax.random.normal(ks.pop(), (N_HYB, CMP_LEN, NSA_HD), f32),
        'hyb_cmp_k_w1': dense((N_HYB, CMP_LEN * NSA_HD, CMP_HID), CMP_LEN * NSA_HD),
        'hyb_cmp_k_w2': dense((N_HYB, CMP_HID, NSA_HD), CMP_HID),
        'hyb_cmp_v_pos': 0.02 * jax.random.normal(ks.pop(), (N_HYB, CMP_LEN, NSA_HD), f32),
        'hyb_cmp_v_w1': dense((N_HYB, CMP_LEN * NSA_HD, CMP_HID), CMP_LEN * NSA_HD),
        'hyb_cmp_v_w2': dense((N_HYB, CMP_HID, NSA_HD), CMP_HID),
        'hyb_gdn_conv': dense((N_HYB, GDN_CONV, 3 * GDN_WIDTH), GDN_CONV),
        'hyb_gdn_a_log': jnp.log(jax.random.uniform(ks.pop(), (N_HYB, GDN_HEADS), f32, 1.0, 16.0)),
        'hyb_gdn_dt_bias': dt + jnp.log(-jnp.expm1(-dt)),
        'hyb_gdn_norm': norm_gain((N_HYB, GDN_HD)),
        'hyb_w_out': dense((N_HYB, MIX_WIDTH, D_MODEL), MIX_WIDTH, 0.5),
        'sc_w_in': dense((N_SC, D_MODEL, 3 * D_MODEL), D_MODEL),
        'sc_conv': dense((N_SC, SC_WIDTH, D_MODEL), SC_WIDTH),
        'sc_w_out': dense((N_SC, D_MODEL, D_MODEL), D_MODEL, 0.5),
        'mem_norm': norm_gain((D_MODEL,)),
        'xa_wq': dense((DEPTH, D_MODEL, XA_WIDTH), D_MODEL),
        'xa_wkv': dense((DEPTH, D_MODEL, 2 * XA_WIDTH), D_MODEL),
        'xa_wo': dense((DEPTH, XA_WIDTH, D_MODEL), XA_WIDTH, 0.5),
        'mlp_w1': dense((DEPTH, D_MODEL, D_FF), D_MODEL),
        'mlp_w2': dense((DEPTH, D_FF, D_MODEL), D_FF, 0.5),
        'final_norm': norm_gain((D_MODEL,)),
    }


def reference(x, mem, positions, norm_mix, norm_xattn, norm_mlp, hyb_w_in, hyb_cmp_k_pos, hyb_cmp_k_w1, hyb_cmp_k_w2, hyb_cmp_v_pos, hyb_cmp_v_w1, hyb_cmp_v_w2, hyb_gdn_conv, hyb_gdn_a_log, hyb_gdn_dt_bias, hyb_gdn_norm, hyb_w_out, sc_w_in, sc_conv, sc_w_out, mem_norm, xa_wq, xa_wkv, xa_wo, mlp_w1, mlp_w2, final_norm):
    mem_n = rms_norm(mem, mem_norm)
    for layer in range(DEPTH):
        j = layer // 2
        hn = rms_norm(x, norm_mix[layer])
        if layer % 2 == 0:
            mix = hybrid_mixer(hn, positions, hyb_w_in[j], hyb_cmp_k_pos[j], hyb_cmp_k_w1[j], hyb_cmp_k_w2[j], hyb_cmp_v_pos[j], hyb_cmp_v_w1[j], hyb_cmp_v_w2[j], hyb_gdn_conv[j], hyb_gdn_a_log[j], hyb_gdn_dt_bias[j], hyb_gdn_norm[j], hyb_w_out[j])
        else:
            mix = short_conv_mixer(hn, sc_w_in[j], sc_conv[j], sc_w_out[j])
        x = x + mix
        x = x + cross_attention(rms_norm(x, norm_xattn[layer]), mem_n, xa_wq[layer], xa_wkv[layer], xa_wo[layer])
        x = x + squared_relu_mlp(rms_norm(x, norm_mlp[layer]), mlp_w1[layer], mlp_w2[layer])
    return rms_norm(x, final_norm)
```

```cpp
#include <hip/hip_runtime.h>
#include <hip/hip_cooperative_groups.h>
#include <cstdio>
namespace cg = cooperative_groups;

#define LAS __attribute__((address_space(3)))
typedef unsigned short bf16_t;
typedef short bf16x8 __attribute__((ext_vector_type(8)));
typedef float f32x4 __attribute__((ext_vector_type(4)));
typedef unsigned u32x4 __attribute__((ext_vector_type(4)));
typedef unsigned u32x2 __attribute__((ext_vector_type(2)));
typedef unsigned long long u64;

constexpr int T_ = 65536, SQ = 4096;
constexpr size_t MiB = 1ull << 20;
constexpr size_t WS_CTL = 0, WS_BIAS1 = 4096, WS_EGL = 8192;
constexpr size_t WS_WIN = 1 * MiB, WS_WVT = 8 * MiB, WS_WCMP1 = 9 * MiB, WS_WOUT = 10 * MiB, WS_WSCIN = 12 * MiB, WS_WSCOUT = 18 * MiB;
constexpr size_t WS_WQ = 20 * MiB, WS_WKM = 22 * MiB, WS_WVM = 24 * MiB, WS_WO = 26 * MiB, WS_W1 = 28 * MiB, WS_W2 = 44 * MiB;
constexpr size_t WS_COS = 60 * MiB, WS_SIN = 68 * MiB, WS_MEMN = 76 * MiB, WS_KMEM = 84 * MiB, WS_VMT = 92 * MiB;
constexpr size_t WS_ACT = 100 * MiB, WS_VT = 228 * MiB, WS_SM = 260 * MiB, WS_HID = 276 * MiB, WS_KC = 280 * MiB, WS_VCT = 281 * MiB;
constexpr size_t WS_HB = 283 * MiB, WS_QN = 667 * MiB, WS_KN = 731 * MiB, WS_VB = 795 * MiB, WS_QKM = 859 * MiB, WS_KDT = 923 * MiB, WS_END = 987 * MiB;
constexpr size_t WS_ACT2 = WS_QKM, WS_SSQ = WS_HID;
constexpr size_t WS_H1 = WS_HB, WS_SC = WS_HB, WS_QX = WS_HB, WS_OX = WS_HB + 64 * MiB;
constexpr int LDS_BYTES = 143360;
constexpr float LOG2E = 1.4426950408889634f;

struct Params { const float* in[28]; float* out; unsigned char* ws; int ph_lo, ph_hi; };

__device__ __forceinline__ unsigned cvt_pk_bf16(float lo, float hi) { unsigned r; asm volatile("v_cvt_pk_bf16_f32 %0, %1, %2" : "=v"(r) : "v"(lo), "v"(hi)); return r; }
__device__ __forceinline__ bf16_t f2bf(float f) { return (bf16_t)(cvt_pk_bf16(f, 0.f) & 0xffffu); }
__device__ __forceinline__ float bf2f(bf16_t b) { return __uint_as_float(((unsigned)b) << 16); }
__device__ __forceinline__ float wave_sum(float v) {
#pragma unroll
    for (int o = 32; o >= 1; o >>= 1) v += __shfl_xor(v, o);
    return v; }
__device__ __forceinline__ float sigmoidf_(float x) { return 1.f / (1.f + __expf(-x)); }
__device__ __forceinline__ float siluf_(float x) { return x / (1.f + __expf(-x)); }
__device__ __forceinline__ int opaque_tid() { int t = threadIdx.x; asm volatile("" : "+v"(t)); return t; }
#define RDLANE(v, i) __int_as_float(__builtin_amdgcn_readlane(__float_as_int(v), (i)))
#define MFMA16(a, b, c) __builtin_amdgcn_mfma_f32_16x16x32_bf16(a, b, c, 0, 0, 0)

namespace pg8 {
constexpr int BM = 256, BK = 64, HALF = 128, HTB = HALF * BK * 2, STAGE_BYTES = 8 * HTB, NXCD = 8, WGM = 8;
__device__ __forceinline__ int lds_byte(int r, int c) { const int st = (r >> 4) * 2 + (c >> 5), rr = r & 15, cc = c & 31, ob = rr * 64 + cc * 2; return st * 1024 + (ob ^ (((ob >> 9) & 1) << 5)); }
__device__ __forceinline__ void stage_rc(int b, int& R, int& C) { const int st = b / 1024, sb = b % 1024, swz = sb ^ (((sb >> 9) & 1) << 5); R = (st >> 1) * 16 + swz / 64; C = (st & 1) * 32 + (swz % 64) / 2; }
__device__ __forceinline__ int perm32(int rho) { const int n = rho >> 4, i = rho & 15; return 8 * (i >> 2) + 4 * n + (i & 3); }
struct Unit { int pm, pn; };
struct Gemm { const bf16_t* A; const bf16_t* Bt; int M, N, K, lda; };
struct StaticOrder {
    int nM, nN, nwg, G, c;
    __device__ void init(int M, int N, int G_, int c_) { nM = M / BM; nN = N / BM; nwg = nM * nN; G = G_; c = c_; }
    __device__ bool next(int i, Unit& u) const {
        const long L = (long)i * G + c; if (L >= nwg) return false;
        int wgid = (int)L; { const int q = nwg / NXCD, r = nwg % NXCD, xcd = wgid % NXCD, off = wgid / NXCD; wgid = (xcd < r ? xcd * (q + 1) : r * (q + 1) + (xcd - r) * q) + off; }
        const int nig = WGM * nN, gid = wgid / nig, fm = gid * WGM, gsz = (nM - fm) < WGM ? (nM - fm) : WGM;
        u.pm = fm + ((wgid % nig) % gsz); u.pn = (wgid % nig) / gsz; return true;
    }
};

template <class Epi>
__device__ __forceinline__ void gemm_phase(LAS unsigned char* lds, const Gemm g, const StaticOrder& S, const Epi& E) {
    const int tid = opaque_tid(), wid = __builtin_amdgcn_readfirstlane(tid >> 6), lane = tid & 63, wr = wid >> 2, wc = wid & 3, fr = lane & 15, fq = lane >> 4;
    const int K = g.K, nt = K / BK, lda = g.lda;
    unsigned voffA[2], voffB[2];
#pragma unroll
    for (int i = 0; i < 2; ++i) { int R, C; stage_rc(tid * 16 + i * 8192, R, C); const int Rb = Epi::PERM ? ((R & ~31) + perm32(R & 31)) : R;
        voffA[i] = (unsigned)(R * lda + C) * 2u; voffB[i] = (unsigned)(Rb * K + C) * 2u; }
    const size_t kstep = (size_t)(BK * 2);
    const size_t hstepA = (size_t)HALF * lda * 2, hstepB = (size_t)HALF * K * 2;
    const size_t tstepA = 2 * hstepA, tstepB = 2 * hstepB;
    const unsigned ldsw = (unsigned)wid * 1024u;
    const int aoff = lds_byte(wr * 64 + fr, fq * 8), boff = lds_byte(wc * 32 + fr, fq * 8);
#define PG8_SA(b, h) (((b) * 2 + (h)) * HTB)
#define PG8_SB(b, h) ((4 + (b) * 2 + (h)) * HTB)
#define PG8_STAGE(bufoff, gbase, voff) do { _Pragma("unroll") for (int _i = 0; _i < 2; ++_i) \
        __builtin_amdgcn_global_load_lds((const unsigned*)((const char*)(gbase) + (voff)[_i]), (LAS unsigned*)(lds + (bufoff) + ldsw + _i * 8192), 16, 0, 0); } while (0)
#define PG8_LDA(dst, b, h) do { _Pragma("unroll") for (int m = 0; m < 4; ++m) _Pragma("unroll") for (int k = 0; k < 2; ++k) dst[m][k] = *(const LAS bf16x8*)(lds + PG8_SA(b, h) + aoff + m * 2048 + k * 1024); } while (0)
#define PG8_LDB(dst, b, h) do { _Pragma("unroll") for (int n = 0; n < 2; ++n) _Pragma("unroll") for (int k = 0; k < 2; ++k) dst[n][k] = *(const LAS bf16x8*)(lds + PG8_SB(b, h) + boff + n * 2048 + k * 1024); } while (0)
#define PG8_MMA(ai, bj, At, Bt) do { __builtin_amdgcn_s_setprio(1); _Pragma("unroll") for (int m = 0; m < 4; ++m) _Pragma("unroll") for (int n = 0; n < 2; ++n) _Pragma("unroll") for (int k = 0; k < 2; ++k) \
        acc[ai][bj][m][n] = __builtin_amdgcn_mfma_f32_16x16x32_bf16(Bt[n][k], At[m][k], acc[ai][bj][m][n], 0, 0, 0); __builtin_amdgcn_s_setprio(0); } while (0)
#define PG8_WAIT_V(n) asm volatile("s_waitcnt vmcnt(" #n ")" ::: "memory")
#define PG8_WAIT_L(n) asm volatile("s_waitcnt lgkmcnt(" #n ")" ::: "memory")
#define PG8_BAR __builtin_amdgcn_s_barrier()
#define PG8_SCHED __builtin_amdgcn_sched_barrier(0)
    Unit cur, nxt; int ui = 0;
    if (!S.next(0, cur)) return;
    f32x4 acc[2][2][4][2];
#pragma unroll
    for (int a = 0; a < 2; ++a)
#pragma unroll
        for (int b = 0; b < 2; ++b)
#pragma unroll
            for (int m = 0; m < 4; ++m)
#pragma unroll
                for (int n = 0; n < 2; ++n) acc[a][b][m][n] = (f32x4){0.f, 0.f, 0.f, 0.f};
    bf16x8 At[4][2], B0[2][2], B1[2][2];
    const char* cA = (const char*)g.A + (size_t)cur.pm * tstepA; const char* cB = (const char*)g.Bt + (size_t)cur.pn * tstepB;
    PG8_STAGE(PG8_SB(0, 0), cB, voffB); PG8_STAGE(PG8_SA(0, 0), cA, voffA); PG8_STAGE(PG8_SB(0, 1), cB + hstepB, voffB); PG8_STAGE(PG8_SA(0, 1), cA + hstepA, voffA);
    if (wr == 1) PG8_BAR;
    PG8_WAIT_V(4); PG8_BAR;
    PG8_STAGE(PG8_SB(1, 0), cB + kstep, voffB); PG8_STAGE(PG8_SA(1, 0), cA + kstep, voffA); PG8_STAGE(PG8_SB(1, 1), cB + hstepB + kstep, voffB);
    PG8_WAIT_V(6); PG8_BAR;
    for (;;) {
        const bool has_next = S.next(ui + 1, nxt);
        const char* nA = has_next ? (const char*)g.A + (size_t)nxt.pm * tstepA : cA; const char* nB = has_next ? (const char*)g.Bt + (size_t)nxt.pn * tstepB : cB;
        for (int t = 0; t < nt; t += 2) {
            const bool last = (t == nt - 2);
            const char* a1 = cA + (size_t)(t + 1) * kstep;
            const char* a2 = last ? nA : cA + (size_t)(t + 2) * kstep; const char* b2 = last ? nB : cB + (size_t)(t + 2) * kstep;
            const char* a3 = a2 + kstep; const char* b3 = b2 + kstep;
            PG8_LDB(B0, 0, 0); PG8_SCHED; PG8_LDA(At, 0, 0); PG8_STAGE(PG8_SA(1, 1), a1 + hstepA, voffA);
            PG8_WAIT_L(8); PG8_BAR; PG8_WAIT_L(0); PG8_MMA(0, 0, At, B0); PG8_BAR; PG8_SCHED;
            PG8_LDB(B1, 0, 1); PG8_STAGE(PG8_SB(0, 0), b2, voffB);
            PG8_BAR; PG8_WAIT_L(0); PG8_MMA(0, 1, At, B1); PG8_BAR;
            PG8_LDA(At, 0, 1); PG8_STAGE(PG8_SA(0, 0), a2, voffA);
            PG8_BAR; PG8_WAIT_L(0); PG8_MMA(1, 0, At, B0); PG8_BAR; PG8_SCHED;
            PG8_STAGE(PG8_SB(0, 1), b2 + hstepB, voffB);
            PG8_WAIT_V(6); PG8_BAR; PG8_MMA(1, 1, At, B1); PG8_BAR;
            PG8_LDB(B0, 1, 0); PG8_SCHED; PG8_LDA(At, 1, 0); PG8_STAGE(PG8_SA(0, 1), a2 + hstepA, voffA);
            PG8_WAIT_L(8); PG8_BAR; PG8_WAIT_L(0); PG8_MMA(0, 0, At, B0); PG8_BAR; PG8_SCHED;
            PG8_LDB(B1, 1, 1); PG8_STAGE(PG8_SB(1, 0), b3, voffB);
            PG8_BAR; PG8_WAIT_L(0); PG8_MMA(0, 1, At, B1); PG8_BAR;
            PG8_LDA(At, 1, 1); PG8_STAGE(PG8_SA(1, 0), a3, voffA);
            PG8_BAR; PG8_WAIT_L(0); PG8_MMA(1, 0, At, B0); PG8_BAR; PG8_SCHED;
            PG8_STAGE(PG8_SB(1, 1), b3 + hstepB, voffB);
            PG8_WAIT_V(6); PG8_BAR; PG8_MMA(1, 1, At, B1); PG8_BAR;
        }
        E(acc, cur, wr, wc, fr, fq);
        if (!has_next) break;
#pragma unroll
        for (int a = 0; a < 2; ++a)
#pragma unroll
            for (int b = 0; b < 2; ++b)
#pragma unroll
                for (int m = 0; m < 4; ++m)
#pragma unroll
                    for (int n = 0; n < 2; ++n) acc[a][b][m][n] = (f32x4){0.f, 0.f, 0.f, 0.f};
        cur = nxt; cA = nA; cB = nB; ++ui;
    }
    PG8_WAIT_V(0);
    if (wr == 0) PG8_BAR;
    PG8_BAR;
#undef PG8_SA
#undef PG8_SB
#undef PG8_STAGE
#undef PG8_LDA
#undef PG8_LDB
#undef PG8_MMA
#undef PG8_WAIT_V
#undef PG8_WAIT_L
#undef PG8_BAR
#undef PG8_SCHED
}

struct EpiBf16 {
    static constexpr bool PERM = true;
    bf16_t* O; int ldc; float scale; int act; const float* ssq;
    __device__ __forceinline__ void operator()(const f32x4 (&acc)[2][2][4][2], const Unit& u, int wr, int wc, int fr, int fq) const {
        const int row0 = u.pm * BM + wr * 64 + fr, col0 = u.pn * BM + wc * 32 + 8 * fq;
        float rscv[2][4];
#pragma unroll
        for (int ai = 0; ai < 2; ++ai)
#pragma unroll
            for (int m = 0; m < 4; ++m) rscv[ai][m] = ssq ? ssq[row0 + ai * HALF + m * 16] : 0.f;
        asm volatile("" ::: "memory");
#pragma unroll
        for (int ai = 0; ai < 2; ++ai)
#pragma unroll
            for (int m = 0; m < 4; ++m) { bf16_t* rowp = O + (size_t)(row0 + ai * HALF + m * 16) * ldc + col0;
                const float rsc = ssq ? scale * rsqrtf(rscv[ai][m] * (1.f / 1024.f) + 1e-6f) : scale;
#pragma unroll
                for (int bj = 0; bj < 2; ++bj) { f32x4 v0 = acc[ai][bj][m][0] * rsc, v1 = acc[ai][bj][m][1] * rsc;
                    if (act == 1) {
#pragma unroll
                        for (int j = 0; j < 4; ++j) { const float a = fmaxf(v0[j], 0.f), b = fmaxf(v1[j], 0.f); v0[j] = a * a; v1[j] = b * b; } }
                    u32x4 w; w.x = cvt_pk_bf16(v0[0], v0[1]); w.y = cvt_pk_bf16(v0[2], v0[3]); w.z = cvt_pk_bf16(v1[0], v1[1]); w.w = cvt_pk_bf16(v1[2], v1[3]);
                    *(u32x4*)(rowp + bj * HALF) = w; } }
    }
};
template <bool BF>
struct EpiResid {
    static constexpr bool PERM = true;
    const void* base; int ldc; bf16_t* XB; float* ssq;
    __device__ __forceinline__ void operator()(const f32x4 (&acc)[2][2][4][2], const Unit& u, int wr, int wc, int fr, int fq) const {
        const int row0 = u.pm * BM + wr * 64 + fr, col0 = u.pn * BM + wc * 32 + 8 * fq;
#pragma unroll
        for (int ai = 0; ai < 2; ++ai) {
            f32x4 bv[4][2][2];
#pragma unroll
            for (int m = 0; m < 4; ++m)
#pragma unroll
                for (int bj = 0; bj < 2; ++bj) { const size_t o_ = (size_t)(row0 + ai * HALF + m * 16) * ldc + col0 + bj * HALF;
                    if (BF) { const u32x4 r_ = *(const u32x4*)((const bf16_t*)base + o_);
                        bv[m][bj][0] = (f32x4){__uint_as_float(r_.x << 16), __uint_as_float(r_.x & 0xffff0000u), __uint_as_float(r_.y << 16), __uint_as_float(r_.y & 0xffff0000u)};
                        bv[m][bj][1] = (f32x4){__uint_as_float(r_.z << 16), __uint_as_float(r_.z & 0xffff0000u), __uint_as_float(r_.w << 16), __uint_as_float(r_.w & 0xffff0000u)}; }
                    else { bv[m][bj][0] = *(const f32x4*)((const float*)base + o_); bv[m][bj][1] = *(const f32x4*)((const float*)base + o_ + 4); } }
            float sq[4];
#pragma unroll
            for (int m = 0; m < 4; ++m) { const size_t off = (size_t)(row0 + ai * HALF + m * 16) * ldc + col0; float s_ = 0.f;
#pragma unroll
                for (int bj = 0; bj < 2; ++bj) { const f32x4 v0 = bv[m][bj][0] + acc[ai][bj][m][0], v1 = bv[m][bj][1] + acc[ai][bj][m][1];
                    s_ += (v0[0] * v0[0] + v0[1] * v0[1]) + (v0[2] * v0[2] + v0[3] * v0[3]) + (v1[0] * v1[0] + v1[1] * v1[1]) + (v1[2] * v1[2] + v1[3] * v1[3]);
                    u32x4 w; w.x = cvt_pk_bf16(v0[0], v0[1]); w.y = cvt_pk_bf16(v0[2], v0[3]); w.z = cvt_pk_bf16(v1[0], v1[1]); w.w = cvt_pk_bf16(v1[2], v1[3]);
                    *(u32x4*)(XB + off + bj * HALF) = w; }
                sq[m] = s_; }
#pragma unroll
            for (int m = 0; m < 4; ++m) { float s_ = sq[m]; s_ += __shfl_xor(s_, 16); s_ += __shfl_xor(s_, 32); if (fq == 0) atomicAdd(ssq + row0 + ai * HALF + m * 16, s_); }
            asm volatile("" ::: "memory");
        }
    }
};
struct EpiCmp1 {
    static constexpr bool PERM = true;
    bf16_t* HID; const float* bias1;
    __device__ __forceinline__ void operator()(const f32x4 (&acc)[2][2][4][2], const Unit& u, int wr, int wc, int fr, int fq) const {
        const int isv = u.pm >= 32 ? 1 : 0; const int row0 = u.pm * BM + wr * 64 + fr, c0 = wc * 32 + 8 * fq;
        const f32x4 b0 = *(const f32x4*)(bias1 + isv * 128 + c0), b1 = *(const f32x4*)(bias1 + isv * 128 + c0 + 4);
#pragma unroll
        for (int ai = 0; ai < 2; ++ai)
#pragma unroll
            for (int m = 0; m < 4; ++m) { bf16_t* rowp = HID + (size_t)(row0 + ai * HALF + m * 16) * 128 + c0;
                f32x4 v0 = (isv ? acc[ai][1][m][0] : acc[ai][0][m][0]) + b0, v1 = (isv ? acc[ai][1][m][1] : acc[ai][0][m][1]) + b1;
#pragma unroll
                for (int j = 0; j < 4; ++j) { v0[j] = siluf_(v0[j]); v1[j] = siluf_(v1[j]); }
                u32x4 w; w.x = cvt_pk_bf16(v0[0], v0[1]); w.y = cvt_pk_bf16(v0[2], v0[3]); w.z = cvt_pk_bf16(v1[0], v1[1]); w.w = cvt_pk_bf16(v1[2], v1[3]);
                *(u32x4*)rowp = w; }
    }
};
struct EpiInproj {
    static constexpr bool PERM = true;
    bf16_t* HB; float* SM;
    __device__ __forceinline__ void operator()(const f32x4 (&acc)[2][2][4][2], const Unit& u, int wr, int wc, int fr, int fq) const {
        const int row0 = u.pm * BM + wr * 64 + fr;
        if (u.pn < 12) {
            const int wpar = wc & 1;
#pragma unroll
            for (int bj = 0; bj < 2; ++bj) {
                const int Hd = u.pn * 4 + bj * 2 + (wc >> 1);
                const unsigned off0 = (((unsigned)Hd * (unsigned)T_ + (unsigned)row0) * 64u + 32u * wpar + 8u * fq) * 2u;
#pragma unroll
                for (int ai = 0; ai < 2; ++ai)
#pragma unroll
                    for (int m = 0; m < 4; ++m) {
                        const f32x4 x1 = acc[ai][bj][m][0], x2 = acc[ai][bj][m][1];
                        u32x4 w; w.x = cvt_pk_bf16(x1[0], x1[1]); w.y = cvt_pk_bf16(x1[2], x1[3]); w.z = cvt_pk_bf16(x2[0], x2[1]); w.w = cvt_pk_bf16(x2[2], x2[3]);
                        *(u32x4*)((char*)HB + (size_t)(off0 + (unsigned)(ai * HALF + m * 16) * 128u)) = w;
                    }
            }
        } else if (wc == 0 || (wc == 1 && fq == 0)) {
#pragma unroll
            for (int n = 0; n < 2; ++n) {
                const int c0 = 32 * wc + 8 * fq + 4 * n;
#pragma unroll
                for (int ai = 0; ai < 2; ++ai)
#pragma unroll
                    for (int m = 0; m < 4; ++m) { const unsigned t = (unsigned)(row0 + ai * HALF + m * 16); *(f32x4*)((char*)SM + (size_t)((t * 64u + (unsigned)c0) * 4u)) = acc[ai][0][m][n]; }
            }
        }
    }
};
}

struct TJob { const float* src; bf16_t* dst; const float* rs; int K, N, ldw, map; };
__device__ __forceinline__ TJob get_job(const Params& p, int j) {
    unsigned char* ws = p.ws; TJob t; t.rs = nullptr; t.map = 0;
    switch (j) {
    case 0: t.src = p.in[6]; t.dst = (bf16_t*)(ws + WS_WIN); t.rs = p.in[3]; t.K = 1024; t.N = 3328; t.ldw = 3368; t.map = 1; break;
    case 1: t.src = p.in[6]; t.dst = (bf16_t*)(ws + WS_WVT); t.rs = p.in[3]; t.K = 1024; t.N = 256; t.ldw = 3368; t.map = 2; break;
    case 2: t.src = p.in[8]; t.dst = (bf16_t*)(ws + WS_WCMP1); t.K = 2048; t.N = 128; t.ldw = 128; break;
    case 3: t.src = p.in[11]; t.dst = (bf16_t*)(ws + WS_WCMP1) + 128 * 2048; t.K = 2048; t.N = 128; t.ldw = 128; break;
    case 4: t.src = p.in[17]; t.dst = (bf16_t*)(ws + WS_WOUT); t.K = 1024; t.N = 1024; t.ldw = 1024; break;
    case 5: t.src = p.in[18]; t.dst = (bf16_t*)(ws + WS_WSCIN); t.rs = p.in[3] + 1024; t.K = 1024; t.N = 3072; t.ldw = 3072; break;
    case 6: t.src = p.in[20]; t.dst = (bf16_t*)(ws + WS_WSCOUT); t.K = 1024; t.N = 1024; t.ldw = 1024; break;
    case 7: case 8: { const int l = j - 7; t.src = p.in[22] + (size_t)l * 1024 * 512; t.dst = (bf16_t*)(ws + WS_WQ) + (size_t)l * 512 * 1024; t.rs = p.in[4] + l * 1024; t.K = 1024; t.N = 512; t.ldw = 512; break; }
    case 9: case 10: { const int l = j - 9; t.src = p.in[23] + (size_t)l * 1024 * 1024; t.dst = (bf16_t*)(ws + WS_WKM) + (size_t)l * 512 * 1024; t.rs = p.in[21]; t.K = 1024; t.N = 512; t.ldw = 1024; break; }
    case 11: case 12: { const int l = j - 11; t.src = p.in[23] + (size_t)l * 1024 * 1024 + 512; t.dst = (bf16_t*)(ws + WS_WVM) + (size_t)l * 512 * 1024; t.rs = p.in[21]; t.K = 1024; t.N = 512; t.ldw = 1024; break; }
    case 13: case 14: { const int l = j - 13; t.src = p.in[24] + (size_t)l * 512 * 1024; t.dst = (bf16_t*)(ws + WS_WO) + (size_t)l * 1024 * 512; t.K = 512; t.N = 1024; t.ldw = 1024; break; }
    case 15: case 16: { const int l = j - 15; t.src = p.in[25] + (size_t)l * 1024 * 4096; t.dst = (bf16_t*)(ws + WS_W1) + (size_t)l * 4096 * 1024; t.rs = p.in[5] + l * 1024; t.K = 1024; t.N = 4096; t.ldw = 4096; break; }
    default: { const int l = j - 17; t.src = p.in[26] + (size_t)l * 4096 * 1024; t.dst = (bf16_t*)(ws + WS_W2) + (size_t)l * 1024 * 4096; t.K = 4096; t.N = 1024; t.ldw = 1024; break; }
    }
    return t;
}
constexpr int NJOBS = 19;
__device__ __forceinline__ int src_col(int map, int n) {
    if (map == 0) return n;
    if (map == 2) { const int vh = n >> 6, d = n & 63; return vh < 2 ? 896 + 64 * vh + d : 1152 + 64 * (vh - 2) + d; }
    if (n < 3072) { const int Hd = n >> 6, P = n & 63; const int d = P;
        int base;
        if (Hd < 8) base = 64 * Hd; else if (Hd < 10) base = 512 + 64 * (Hd - 8); else if (Hd < 12) base = 640 + 64 * (Hd - 10);
        else if (Hd < 14) base = 768 + 64 * (Hd - 12); else if (Hd < 16) base = 1024 + 64 * (Hd - 14); else if (Hd < 24) base = 1304 + 64 * (Hd - 16);
        else if (Hd < 32) base = 1816 + 64 * (Hd - 24); else if (Hd < 40) base = 2328 + 64 * (Hd - 32); else base = 2856 + 64 * (Hd - 40);
        return base + d; }
    const int c = n - 3072;
    if (c < 24) return 1280 + c; if (c < 32) return 2840 + (c - 24); if (c < 40) return 2848 + (c - 32);
    return -1;
}
__device__ __forceinline__ void rms_rows_bf16(const float* __restrict__ X, bf16_t* __restrict__ O, int rows, int gw, int nw, int lane) {
    for (int r = gw; r < rows; r += 2 * nw) {
        const int r2 = r + nw < rows ? r + nw : r;
        const float* xa = X + (size_t)r * 1024; const float* xb = X + (size_t)r2 * 1024; f32x4 va[4], vb[4]; float sa = 0.f, sb = 0.f;
#pragma unroll
        for (int i = 0; i < 4; ++i) { va[i] = *(const f32x4*)(xa + i * 256 + lane * 4); vb[i] = *(const f32x4*)(xb + i * 256 + lane * 4); }
#pragma unroll
        for (int i = 0; i < 4; ++i) { sa += va[i][0] * va[i][0] + va[i][1] * va[i][1] + va[i][2] * va[i][2] + va[i][3] * va[i][3]; sb += vb[i][0] * vb[i][0] + vb[i][1] * vb[i][1] + vb[i][2] * vb[i][2] + vb[i][3] * vb[i][3]; }
#pragma unroll
        for (int o = 32; o >= 1; o >>= 1) { sa += __shfl_xor(sa, o); sb += __shfl_xor(sb, o); }
        const float ra = rsqrtf(sa * (1.f / 1024.f) + 1e-6f), rb = rsqrtf(sb * (1.f / 1024.f) + 1e-6f);
#pragma unroll
        for (int i = 0; i < 4; ++i) { u32x2 w; w.x = cvt_pk_bf16(va[i][0] * ra, va[i][1] * ra); w.y = cvt_pk_bf16(va[i][2] * ra, va[i][3] * ra); *(u32x2*)(O + (size_t)r * 1024 + i * 256 + lane * 4) = w;
            w.x = cvt_pk_bf16(vb[i][0] * rb, vb[i][1] * rb); w.y = cvt_pk_bf16(vb[i][2] * rb, vb[i][3] * rb); *(u32x2*)(O + (size_t)r2 * 1024 + i * 256 + lane * 4) = w; }
    }
}
__device__ void phase_prep(const Params& p, unsigned char* lds) {
    const int tid = opaque_tid(), lane = tid & 63, wid = __builtin_amdgcn_readfirstlane(tid >> 6), G = gridDim.x, bid = blockIdx.x;
    const int gw = bid * 8 + wid, nw = G * 8;
    unsigned char* ws = p.ws;
    if (bid == 0 && tid < 64) ((unsigned*)(ws + WS_CTL))[tid] = 0u;
    {
        int tbase = 0;
        for (int j = 0; j < NJOBS; ++j) {
            const TJob jb = get_job(p, j);
            const int nnt = jb.N / 64, ntl = (jb.K / 64) * nnt;
            for (int lt = ((gw - tbase % nw) + nw) % nw; lt < ntl; lt += nw) {
                const int k0 = (lt / nnt) * 64, n0 = (lt % nnt) * 64;
                const int sc = src_col(jb.map, n0 + lane);
                const float* src = jb.src + (size_t)k0 * jb.ldw + (sc >= 0 ? sc : 0);
                float v[64];
#pragma unroll
                for (int k = 0; k < 64; ++k) v[k] = src[(size_t)k * jb.ldw];
                if (jb.rs) {
#pragma unroll
                    for (int k = 0; k < 64; ++k) v[k] *= jb.rs[k0 + k]; }
                if (sc < 0) {
#pragma unroll
                    for (int k = 0; k < 64; ++k) v[k] = 0.f; }
                bf16_t* dst = jb.dst + (size_t)(n0 + lane) * jb.K + k0;
#pragma unroll
                for (int k8 = 0; k8 < 8; ++k8) { u32x4 w; w.x = cvt_pk_bf16(v[8 * k8], v[8 * k8 + 1]); w.y = cvt_pk_bf16(v[8 * k8 + 2], v[8 * k8 + 3]); w.z = cvt_pk_bf16(v[8 * k8 + 4], v[8 * k8 + 5]); w.w = cvt_pk_bf16(v[8 * k8 + 6], v[8 * k8 + 7]); *(u32x4*)(dst + 8 * k8) = w; }
            }
            tbase += ntl;
        }
    }
    if (gw < 256) { const int c = gw, isv = c >> 7; const float* w1 = isv ? p.in[11] : p.in[8]; const float* pos = isv ? p.in[10] : p.in[7]; float s = 0.f;
        for (int k = lane; k < 2048; k += 64) s += pos[k] * w1[(size_t)k * 128 + (c & 127)];
        s = wave_sum(s); if (lane == 0) ((float*)(ws + WS_BIAS1))[c] = s; }
    { float* COS = (float*)(ws + WS_COS); float* SIN = (float*)(ws + WS_SIN); const int* pos = (const int*)p.in[2];
      for (int e = bid * 512 + tid; e < T_ * 32; e += G * 512) { const int t = e >> 5, i = e & 31; const float invf = powf(10000.f, -(float)(2 * i) / 64.f); const float ang = (float)pos[t] * invf; float sn, cs; sincosf(ang, &sn, &cs); COS[e] = cs; SIN[e] = sn; } }
    rms_rows_bf16(p.in[1], (bf16_t*)(ws + WS_MEMN), 4096, gw, nw, lane);
    rms_rows_bf16(p.in[0], (bf16_t*)(ws + WS_ACT), T_, gw, nw, lane);
}

template <int D, int KST>
__device__ __forceinline__ void qk_tile(const LAS bf16_t* Kt, const bf16x8 (&qf)[D / 32], f32x4 (&st)[4], int lane) {
    const int r = lane & 15, q4 = lane >> 4;
#pragma unroll
    for (int ti = 0; ti < 4; ++ti) {
        const int key = 32 * (ti >> 1) + (r >> 2) * 8 + 4 * (ti & 1) + (r & 3);
        f32x4 a = (f32x4){0.f, 0.f, 0.f, 0.f};
#pragma unroll
        for (int kc = 0; kc < D / 32; ++kc) { const bf16x8 kA = *(const LAS bf16x8*)(Kt + key * KST + 32 * (key >> 4) + 32 * kc + 8 * q4); a = MFMA16(kA, qf[kc], a); }
        st[ti] = a;
    }
}
template <int D, int VST>
__device__ __forceinline__ void pv_tile(const LAS bf16_t* Vt, const f32x4 (&pp)[4], f32x4 (&o)[D / 16], int lane) {
    const int r = lane & 15, q4 = lane >> 4;
#pragma unroll
    for (int c2 = 0; c2 < 2; ++c2) {
        u32x4 pk; pk.x = cvt_pk_bf16(pp[2 * c2][0], pp[2 * c2][1]); pk.y = cvt_pk_bf16(pp[2 * c2][2], pp[2 * c2][3]); pk.z = cvt_pk_bf16(pp[2 * c2 + 1][0], pp[2 * c2 + 1][1]); pk.w = cvt_pk_bf16(pp[2 * c2 + 1][2], pp[2 * c2 + 1][3]);
        const bf16x8 pB = __builtin_bit_cast(bf16x8, pk);
#pragma unroll
        for (int dt = 0; dt < D / 16; ++dt) { const bf16x8 vA = *(const LAS bf16x8*)(Vt + (16 * dt + r) * VST + 32 * c2 + 8 * q4); o[dt] = MFMA16(vA, pB, o[dt]); }
    }
}
template <int D, int VST>
__device__ __forceinline__ void softmax_pv(f32x4 (&st)[4], unsigned vm, float& mrun, float& lrun, f32x4 (&o)[D / 16], const LAS bf16_t* Vt, int lane) {
    float mx = -1e30f;
#pragma unroll
    for (int ti = 0; ti < 4; ++ti)
#pragma unroll
        for (int jj = 0; jj < 4; ++jj) if ((vm >> (ti * 4 + jj)) & 1u) mx = fmaxf(mx, st[ti][jj]);
    mx = fmaxf(mx, __shfl_xor(mx, 16)); mx = fmaxf(mx, __shfl_xor(mx, 32));
    const float mn = fmaxf(mrun, mx); const float alpha = __builtin_amdgcn_exp2f(mrun - mn); mrun = mn;
    float rs = 0.f;
#pragma unroll
    for (int ti = 0; ti < 4; ++ti)
#pragma unroll
        for (int jj = 0; jj < 4; ++jj) { const float pv = ((vm >> (ti * 4 + jj)) & 1u) ? __builtin_amdgcn_exp2f(st[ti][jj] - mn) : 0.f; st[ti][jj] = pv; rs += pv; }
    lrun = lrun * alpha + rs;
#pragma unroll
    for (int dt = 0; dt < D / 16; ++dt) o[dt] *= alpha;
    pv_tile<D, VST>(Vt, st, o, lane);
}

template <int D, int KST>
__device__ __forceinline__ void qk_tile_bias(const LAS bf16_t* Kt, const bf16x8 (&qf)[D / 32], f32x4 (&st)[4], float bias, int lane) {
    const int r = lane & 15, q4 = lane >> 4;
#pragma unroll
    for (int ti = 0; ti < 4; ++ti) {
        const int key = 32 * (ti >> 1) + (r >> 2) * 8 + 4 * (ti & 1) + (r & 3);
        f32x4 a = (f32x4){bias, bias, bias, bias};
#pragma unroll
        for (int kc = 0; kc < D / 32; ++kc) { const bf16x8 kA = *(const LAS bf16x8*)(Kt + key * KST + 32 * (key >> 4) + 32 * kc + 8 * q4); a = MFMA16(kA, qf[kc], a); }
        st[ti] = a;
    }
}
#define SM_THR 8.0f
template <int D, int VST>
__device__ __forceinline__ void softmax_pv_fast(f32x4 (&st)[4], float& mrun, float& lrun, f32x4 (&o)[D / 16], const LAS bf16_t* Vt, int lane) {
    float mx = fmaxf(fmaxf(fmaxf(st[0][0], st[0][1]), fmaxf(st[0][2], st[0][3])), fmaxf(fmaxf(st[1][0], st[1][1]), fmaxf(st[1][2], st[1][3])));
    mx = fmaxf(mx, fmaxf(fmaxf(fmaxf(st[2][0], st[2][1]), fmaxf(st[2][2], st[2][3])), fmaxf(fmaxf(st[3][0], st[3][1]), fmaxf(st[3][2], st[3][3]))));
    if (__any(mx - mrun > SM_THR)) {
        mx = fmaxf(mx, __shfl_xor(mx, 16)); mx = fmaxf(mx, __shfl_xor(mx, 32));
        const float mn = fmaxf(mrun, mx); const float alpha = __builtin_amdgcn_exp2f(mrun - mn); mrun = mn;
        lrun *= alpha;
#pragma unroll
        for (int dt = 0; dt < D / 16; ++dt) o[dt] *= alpha;
    }
    f32x4 rs4 = (f32x4){0.f, 0.f, 0.f, 0.f};
#pragma unroll
    for (int ti = 0; ti < 4; ++ti) { const f32x4 d = st[ti] - mrun; f32x4 e; e[0] = __builtin_amdgcn_exp2f(d[0]); e[1] = __builtin_amdgcn_exp2f(d[1]); e[2] = __builtin_amdgcn_exp2f(d[2]); e[3] = __builtin_amdgcn_exp2f(d[3]); st[ti] = e; rs4 += e; }
    lrun += (rs4[0] + rs4[1]) + (rs4[2] + rs4[3]);
    pv_tile<D, VST>(Vt, st, o, lane);
}

constexpr int NSA_KC = 0, NSA_VC = 38912, NSA_PS = 72704, NSA_IMP = 105472, NSA_MASK = 113664;
constexpr int KT72 = 64 * 72 + 128, KT136 = 64 * 136 + 128;
__device__ void nsa_item(const Params& p, unsigned char* ldsg, int item) {
    LAS unsigned char* lds = (LAS unsigned char*)ldsg;
    const int tid = opaque_tid(), lane = tid & 63, wid = __builtin_amdgcn_readfirstlane(tid >> 6), c = lane & 15, q4 = lane >> 4, tl = c >> 2, hh = c & 3;
    const int bg = item & 31, qt = 127 - (item >> 5), g = bg >> 4, b = bg & 15, t0 = qt * 32;
    const int t = t0 + 4 * wid + tl, h = 4 * g + hh, tok = b * SQ + t;
    unsigned char* ws = p.ws;
    const bf16_t* HB = (const bf16_t*)(ws + WS_HB); const float* SM = (const float*)(ws + WS_SM);
    bf16x8 qf[2];
    { const bf16_t* qrow = HB + ((size_t)(h * 16 + b) * SQ + t) * 64; qf[0] = *(const bf16x8*)(qrow + 8 * q4); qf[1] = *(const bf16x8*)(qrow + 32 + 8 * q4); }
    const float gate0 = sigmoidf_(SM[(size_t)tok * 64 + h * 3 + 0]), gate1 = sigmoidf_(SM[(size_t)tok * 64 + h * 3 + 1]), gate2 = sigmoidf_(SM[(size_t)tok * 64 + h * 3 + 2]);
    f32x4 outacc[4];
#pragma unroll
    for (int dt = 0; dt < 4; ++dt) outacc[dt] = (f32x4){0.f, 0.f, 0.f, 0.f};
    LAS bf16_t* Kc = (LAS bf16_t*)(lds + NSA_KC); LAS bf16_t* Vc = (LAS bf16_t*)(lds + NSA_VC);
    LAS float* PS = (LAS float*)(lds + NSA_PS); LAS float* IMP = (LAS float*)(lds + NSA_IMP); LAS u64* MASK = (LAS u64*)(lds + NSA_MASK);
    {
        int nvmax = t0 / 16 + 1; if (nvmax > 255) nvmax = 255;
        const int ntc = (nvmax + 63) >> 6;
        const bf16_t* KCg = (const bf16_t*)(ws + WS_KC) + (size_t)bg * 256 * 64; const bf16_t* VCg = (const bf16_t*)(ws + WS_VCT) + (size_t)bg * 64 * 256;
        { const int lr_ = tid >> 3, lc_ = (tid & 7) * 8; u32x4 kr[4], vr[4];
#pragma unroll
          for (int kt = 0; kt < 4; ++kt) if (kt < ntc) { kr[kt] = *(const u32x4*)(KCg + (size_t)(64 * kt + lr_) * 64 + lc_); vr[kt] = *(const u32x4*)(VCg + (size_t)lr_ * 256 + 64 * kt + lc_); }
#pragma unroll
          for (int kt = 0; kt < 4; ++kt) if (kt < ntc) { *(LAS u32x4*)(Kc + kt * KT72 + lr_ * 72 + 32 * (lr_ >> 4) + lc_) = kr[kt]; *(LAS u32x4*)(Vc + lr_ * 264 + 64 * kt + lc_) = vr[kt]; } }
        __syncthreads();
        const int nv = (t >= 31) ? (t - 31) / 16 + 1 : 0;
        f32x4 sc[4][4];
#pragma unroll
        for (int kt = 0; kt < 4; ++kt) {
            if (kt < ntc) qk_tile<64, 72>(Kc + kt * KT72, qf, sc[kt], lane);
            else {
#pragma unroll
                for (int ti = 0; ti < 4; ++ti) sc[kt][ti] = (f32x4){0.f, 0.f, 0.f, 0.f}; }
        }
        float mx = -1e30f;
#pragma unroll
        for (int kt = 0; kt < 4; ++kt)
#pragma unroll
            for (int ti = 0; ti < 4; ++ti)
#pragma unroll
                for (int jj = 0; jj < 4; ++jj) { const int n = 64 * kt + 32 * (ti >> 1) + 8 * q4 + 4 * (ti & 1) + jj; if (n < nv) mx = fmaxf(mx, sc[kt][ti][jj]); }
        mx = fmaxf(mx, __shfl_xor(mx, 16)); mx = fmaxf(mx, __shfl_xor(mx, 32));
        float ls = 0.f;
#pragma unroll
        for (int kt = 0; kt < 4; ++kt)
#pragma unroll
            for (int ti = 0; ti < 4; ++ti)
#pragma unroll
                for (int jj = 0; jj < 4; ++jj) { const int n = 64 * kt + 32 * (ti >> 1) + 8 * q4 + 4 * (ti & 1) + jj; const float pv = (n < nv) ? __builtin_amdgcn_exp2f(sc[kt][ti][jj] - mx) : 0.f; sc[kt][ti][jj] = pv; ls += pv; }
        ls += __shfl_xor(ls, 16); ls += __shfl_xor(ls, 32);
        const float inv = ls > 0.f ? 1.f / ls : 0.f;
#pragma unroll
        for (int kt = 0; kt < 4; ++kt)
#pragma unroll
            for (int ti = 0; ti < 4; ++ti)
#pragma unroll
                for (int jj = 0; jj < 4; ++jj) { const float pn = sc[kt][ti][jj] * inv; sc[kt][ti][jj] = pn; float v = pn; v += __shfl_xor(v, 1); v += __shfl_xor(v, 2);
                    if (hh == 0) PS[(4 * wid + tl) * 256 + 64 * kt + 32 * (ti >> 1) + 8 * q4 + 4 * (ti & 1) + jj] = v; }
        f32x4 o[4];
#pragma unroll
        for (int dt = 0; dt < 4; ++dt) o[dt] = (f32x4){0.f, 0.f, 0.f, 0.f};
#pragma unroll
        for (int kt = 0; kt < 4; ++kt) if (kt < ntc) pv_tile<64, 264>(Vc + 64 * kt, sc[kt], o, lane);
#pragma unroll
        for (int dt = 0; dt < 4; ++dt) outacc[dt] += o[dt] * gate0;
    }
    __syncthreads();
    const u32x4 kv_first = *(const u32x4*)(HB + (size_t)(12 + g) * 16 * SQ * 64 + (size_t)b * SQ * 64 + (size_t)(tid >> 3) * 64 + (tid & 7) * 8);
    const u32x4 vv_first = *(const u32x4*)((const bf16_t*)(ws + WS_VT) + (size_t)g * 64 * T_ + (size_t)b * SQ + (size_t)(tid >> 3) * T_ + (tid & 7) * 8);
    {
        const int tk = tid >> 4, tq = t0 + tk, cur = tq >> 6;
#pragma unroll
        for (int e = 0; e < 4; ++e) { const int jb = (tid & 15) + 16 * e; const LAS float* pr = PS + tk * 256 + 4 * jb;
            float v = pr[0] + pr[1] + pr[2] + 0.5f * pr[3] + (jb > 0 ? 0.5f * pr[-1] : 0.f);
            const bool forced = (jb == 0) || (jb == cur) || (jb == cur - 1);
            v = (jb <= cur) ? (forced ? v + 1000.f : v) : -1.f;
            IMP[tk * 64 + jb] = v; }
    }
    __syncthreads();
    {
        const float v0 = IMP[(4 * wid + 0) * 64 + lane], v1 = IMP[(4 * wid + 1) * 64 + lane], v2 = IMP[(4 * wid + 2) * 64 + lane], v3 = IMP[(4 * wid + 3) * 64 + lane];
        int r0 = 0, r1 = 0, r2 = 0, r3 = 0;
#pragma unroll
        for (int j = 0; j < 64; ++j) { const float s0 = RDLANE(v0, j), s1 = RDLANE(v1, j), s2 = RDLANE(v2, j), s3 = RDLANE(v3, j); const bool lo = j < lane;
            r0 += (s0 > v0 || (s0 == v0 && lo)) ? 1 : 0; r1 += (s1 > v1 || (s1 == v1 && lo)) ? 1 : 0; r2 += (s2 > v2 || (s2 == v2 && lo)) ? 1 : 0; r3 += (s3 > v3 || (s3 == v3 && lo)) ? 1 : 0; }
        const u64 m0 = __ballot(r0 < 16), m1 = __ballot(r1 < 16), m2 = __ballot(r2 < 16), m3 = __ballot(r3 < 16);
        if (lane == 0) { MASK[4 * wid + 0] = m0; MASK[4 * wid + 1] = m1; MASK[4 * wid + 2] = m2; MASK[4 * wid + 3] = m3; }
    }
    __syncthreads();
    const u64 mymask = MASK[4 * wid + tl];
    u64 uni = MASK[lane & 31];
#pragma unroll
    for (int o = 16; o >= 1; o >>= 1) uni |= __shfl_xor(uni, o);
    const int cur = t0 >> 6;
    uni &= (cur == 63) ? ~0ull : ((2ull << cur) - 1ull);
    uni = ((u64)(unsigned)__builtin_amdgcn_readfirstlane((unsigned)(uni >> 32)) << 32) | (u64)(unsigned)__builtin_amdgcn_readfirstlane((unsigned)uni);
    const bf16_t* VTg = (const bf16_t*)(ws + WS_VT);
#pragma unroll 1
    for (int br = 1; br <= 2; ++br) {
        const bf16_t* Kg = HB + (size_t)((br == 1 ? 12 : 14) + g) * 16 * SQ * 64 + (size_t)b * SQ * 64;
        const bf16_t* Vg = VTg + (size_t)((br == 1 ? 0 : 2) + g) * 64 * T_ + (size_t)b * SQ;
        u64 list;
        if (br == 1) list = uni;
        else { const int lo = (t0 >= 511 ? (t0 - 511) >> 6 : 0), hi = t0 >> 6; list = ((hi == 63) ? ~0ull : ((2ull << hi) - 1ull)) & ~((1ull << lo) - 1ull); }
        float mrun = -1e30f, lrun = 0.f; f32x4 o[4];
#pragma unroll
        for (int dt = 0; dt < 4; ++dt) o[dt] = (f32x4){0.f, 0.f, 0.f, 0.f};
        const int lr = tid >> 3, lch = tid & 7;
        int j = __builtin_ctzll(list); list &= list - 1;
        { u32x4 kv = kv_first, vv = vv_first;
          if (br != 1) { kv = *(const u32x4*)(Kg + (size_t)(64 * j + lr) * 64 + lch * 8); vv = *(const u32x4*)(Vg + (size_t)lr * T_ + 64 * j + lch * 8); }
          *(LAS u32x4*)(Kc + lr * 72 + 32 * (lr >> 4) + lch * 8) = kv; *(LAS u32x4*)(Vc + lr * 72 + lch * 8) = vv; }
        __syncthreads();
        int buf = 0;
        for (;;) {
            const int jn = list ? __builtin_ctzll(list) : -1; list &= list - 1;
            u32x4 kv, vv;
            if (jn >= 0) { kv = *(const u32x4*)(Kg + (size_t)(64 * jn + lr) * 64 + lch * 8); vv = *(const u32x4*)(Vg + (size_t)lr * T_ + 64 * jn + lch * 8); }
            unsigned vm = 0u;
            if (br == 1) { if ((mymask >> j) & 1ull) { if (j < cur) vm = 0xffffu; else {
#pragma unroll
                        for (int ti = 0; ti < 4; ++ti)
#pragma unroll
                            for (int jj = 0; jj < 4; ++jj) { const int key = 64 * j + 32 * (ti >> 1) + 8 * q4 + 4 * (ti & 1) + jj; if (key <= t) vm |= 1u << (ti * 4 + jj); } } } }
            else {
                const int tw0 = t0 + 4 * wid;
                if (64 * j + 63 <= tw0 && 64 * j > tw0 + 3 - 512) vm = 0xffffu;
                else {
#pragma unroll
                    for (int ti = 0; ti < 4; ++ti)
#pragma unroll
                        for (int jj = 0; jj < 4; ++jj) { const int key = 64 * j + 32 * (ti >> 1) + 8 * q4 + 4 * (ti & 1) + jj; if (key <= t && key > t - 512) vm |= 1u << (ti * 4 + jj); } } }
            if (__any(vm != 0u)) { f32x4 st[4];
                if (!__any(vm != 0u && vm != 0xffffu)) { qk_tile_bias<64, 72>(Kc + buf * KT72, qf, st, vm ? 0.f : -INFINITY, lane); softmax_pv_fast<64, 72>(st, mrun, lrun, o, Vc + buf * 4608, lane); }
                else { qk_tile<64, 72>(Kc + buf * KT72, qf, st, lane); softmax_pv<64, 72>(st, vm, mrun, lrun, o, Vc + buf * 4608, lane); } }
            if (jn >= 0) { *(LAS u32x4*)(Kc + (buf ^ 1) * KT72 + lr * 72 + 32 * (lr >> 4) + lch * 8) = kv; *(LAS u32x4*)(Vc + (buf ^ 1) * 4608 + lr * 72 + lch * 8) = vv; }
            __syncthreads();
            if (jn < 0) break;
            j = jn; buf ^= 1;
        }
        float lt = lrun; lt += __shfl_xor(lt, 16); lt += __shfl_xor(lt, 32);
        const float sc_ = (br == 1 ? gate1 : gate2) * (lt > 0.f ? 1.f / lt : 0.f);
#pragma unroll
        for (int dt = 0; dt < 4; ++dt) outacc[dt] += o[dt] * sc_;
    }
    { bf16_t* dst = (bf16_t*)(ws + WS_ACT) + (size_t)tok * 1024 + h * 64 + 4 * q4;
#pragma unroll
      for (int dt = 0; dt < 4; ++dt) { u32x2 w; w.x = cvt_pk_bf16(outacc[dt][0], outacc[dt][1]); w.y = cvt_pk_bf16(outacc[dt][2], outacc[dt][3]); *(u32x2*)(dst + 16 * dt) = w; } }
}

__device__ void xattn_block(const Params& p, unsigned char* ldsg, int blk, int layer) {
    LAS unsigned char* lds = (LAS unsigned char*)ldsg;
    const int tid = opaque_tid(), lane = tid & 63, wid = __builtin_amdgcn_readfirstlane(tid >> 6), c = lane & 15, q4 = lane >> 4;
    const int qq = blk & 3, h = (blk >> 2) & 3, b = blk >> 4;
    unsigned char* ws = p.ws;
    const bf16_t* QX = (const bf16_t*)(ws + WS_QX); const bf16_t* KM = (const bf16_t*)(ws + WS_KMEM) + (size_t)layer * 4096 * 512; const bf16_t* VM = (const bf16_t*)(ws + WS_VMT) + (size_t)layer * 512 * 4096;
    LAS bf16_t* Kb = (LAS bf16_t*)lds;
    LAS bf16_t* Vb = (LAS bf16_t*)(lds + 4 * KT136 * 2);
    __syncthreads();
#pragma unroll
    for (int i = 0; i < 8; ++i) { const int e = tid + 512 * i; const int row = e >> 4, rl = row & 63; *(LAS u32x4*)(Kb + (row >> 6) * KT136 + rl * 136 + 32 * (rl >> 4) + (e & 15) * 8) = *(const u32x4*)(KM + (size_t)(b * 256 + row) * 512 + h * 128 + (e & 15) * 8); }
#pragma unroll
    for (int i = 0; i < 8; ++i) { const int e = tid + 512 * i; *(LAS u32x4*)(Vb + (e >> 5) * 264 + (e & 31) * 8) = *(const u32x4*)(VM + (size_t)(h * 128 + (e >> 5)) * 4096 + b * 256 + (e & 31) * 8); }
    __syncthreads();
    bf16x8 qn[4];
#pragma unroll
    for (int kc = 0; kc < 4; ++kc) qn[kc] = *(const bf16x8*)(QX + (size_t)(b * SQ + (qq * 8) * 128 + wid * 16 + c) * 512 + h * 128 + 32 * kc + 8 * q4);
#pragma unroll 1
    for (int qt = 0; qt < 8; ++qt) {
        const int tok = b * SQ + (qq * 8 + qt) * 128 + wid * 16 + c;
        bf16x8 qf[4];
#pragma unroll
        for (int kc = 0; kc < 4; ++kc) qf[kc] = qn[kc];
        if (qt < 7) {
#pragma unroll
            for (int kc = 0; kc < 4; ++kc) qn[kc] = *(const bf16x8*)(QX + (size_t)(tok + 128) * 512 + h * 128 + 32 * kc + 8 * q4); }
        float mrun = -1e30f, lrun = 0.f; f32x4 o[8];
#pragma unroll
        for (int dt = 0; dt < 8; ++dt) o[dt] = (f32x4){0.f, 0.f, 0.f, 0.f};
#pragma unroll 1
        for (int j = 0; j < 4; ++j) { f32x4 st[4]; qk_tile<128, 136>(Kb + j * KT136, qf, st, lane); softmax_pv_fast<128, 264>(st, mrun, lrun, o, Vb + 64 * j, lane); }
        float lt = lrun; lt += __shfl_xor(lt, 16); lt += __shfl_xor(lt, 32);
        const float inv = 1.f / lt;
        bf16_t* dst = (bf16_t*)(ws + WS_OX) + (size_t)tok * 512 + h * 128 + 4 * q4;
#pragma unroll
        for (int dt = 0; dt < 8; ++dt) { u32x2 w; w.x = cvt_pk_bf16(o[dt][0] * inv, o[dt][1] * inv); w.y = cvt_pk_bf16(o[dt][2] * inv, o[dt][3] * inv); *(u32x2*)(dst + 16 * dt) = w; }
    }
}

__device__ void gdn_g1(const Params& p, int gw, int nw, int lane) {
    unsigned char* ws = p.ws;
    const bf16_t* __restrict__ HB = (const bf16_t*)(ws + WS_HB); const float* __restrict__ SM = (const float*)(ws + WS_SM); const float* __restrict__ cw = p.in[13];
    bf16_t* __restrict__ QN = (bf16_t*)(ws + WS_QN); bf16_t* __restrict__ KN = (bf16_t*)(ws + WS_KN); bf16_t* __restrict__ VB = (bf16_t*)(ws + WS_VB);
    const int tl = lane >> 4, dq = (lane & 15) * 4;
    for (int cid = gw; cid < 8192; cid += nw) {
        const int bh = cid >> 6, cc = cid & 63, h = bh >> 4, b = bh & 15, s0 = cc * 64;
        const bf16_t* xs[3] = { HB + ((size_t)((16 + h) * 16 + b) * SQ) * 64 + dq, HB + ((size_t)((24 + h) * 16 + b) * SQ) * 64 + dq, HB + ((size_t)((32 + h) * 16 + b) * SQ) * 64 + dq };
        f32x4 wt[3][4];
#pragma unroll
        for (int x = 0; x < 3; ++x)
#pragma unroll
            for (int j = 0; j < 4; ++j) wt[x][j] = *(const f32x4*)(cw + j * 1536 + x * 512 + h * 64 + dq);
#pragma unroll 4
        for (int it = 0; it < 16; ++it) {
            const int s = s0 + 4 * it + tl;
            f32x4 y[3];
#pragma unroll
            for (int x = 0; x < 3; ++x) {
                f32x4 acc = (f32x4){0.f, 0.f, 0.f, 0.f};
#pragma unroll
                for (int j = 0; j < 4; ++j) { const int sj = s - 3 + j; u32x2 raw = (u32x2){0u, 0u}; if (sj >= 0) raw = *(const u32x2*)(xs[x] + (size_t)sj * 64);
                    const f32x4 xv = (f32x4){bf2f((bf16_t)(raw.x & 0xffff)), bf2f((bf16_t)(raw.x >> 16)), bf2f((bf16_t)(raw.y & 0xffff)), bf2f((bf16_t)(raw.y >> 16))};
                    acc += wt[x][j] * xv; }
#pragma unroll
                for (int e = 0; e < 4; ++e) acc[e] = siluf_(acc[e]);
                y[x] = acc;
            }
            float sq = y[0][0] * y[0][0] + y[0][1] * y[0][1] + y[0][2] * y[0][2] + y[0][3] * y[0][3], sk = y[1][0] * y[1][0] + y[1][1] * y[1][1] + y[1][2] * y[1][2] + y[1][3] * y[1][3];
#pragma unroll
            for (int o = 1; o < 16; o <<= 1) { sq += __shfl_xor(sq, o); sk += __shfl_xor(sk, o); }
            const float rq = rsqrtf(sq + 1e-6f) * 0.125f, rk = rsqrtf(sk + 1e-6f);
            const float beta = sigmoidf_(SM[(size_t)(b * SQ + s) * 64 + 32 + h]);
            const size_t o = (size_t)cid * 4096 + (4 * it + tl) * 64 + dq;
            u32x2 w; w.x = cvt_pk_bf16(y[0][0] * rq, y[0][1] * rq); w.y = cvt_pk_bf16(y[0][2] * rq, y[0][3] * rq); *(u32x2*)(QN + o) = w;
            w.x = cvt_pk_bf16(y[1][0] * rk, y[1][1] * rk); w.y = cvt_pk_bf16(y[1][2] * rk, y[1][3] * rk); *(u32x2*)(KN + o) = w;
            w.x = cvt_pk_bf16(y[2][0] * beta, y[2][1] * beta); w.y = cvt_pk_bf16(y[2][2] * beta, y[2][3] * beta); *(u32x2*)(VB + o) = w;
        }
    }
}
__device__ void gdn_g2(const Params& p, LAS float* Aw, int cid, int lane) {
    unsigned char* ws = p.ws;
    const float* SM = (const float*)(ws + WS_SM);
    bf16_t* QN = (bf16_t*)(ws + WS_QN) + (size_t)cid * 4096; bf16_t* KN = (bf16_t*)(ws + WS_KN) + (size_t)cid * 4096; bf16_t* VB = (bf16_t*)(ws + WS_VB) + (size_t)cid * 4096;
    bf16_t* QKM = (bf16_t*)(ws + WS_QKM) + (size_t)cid * 4096; bf16_t* KDT = (bf16_t*)(ws + WS_KDT) + (size_t)cid * 4096;
    const int r = lane & 15, q4 = lane >> 4;
    const int bh = cid >> 6, cc = cid & 63, h = bh >> 4, b = bh & 15, tok0 = b * SQ + cc * 64;
    float gcs; { const float xx = SM[(size_t)(tok0 + lane) * 64 + 24 + h] + p.in[15][h]; const float sp = xx > 20.f ? xx : log1pf(__expf(xx)); gcs = -__expf(p.in[14][h]) * sp; }
    const float beta = sigmoidf_(SM[(size_t)(tok0 + lane) * 64 + 32 + h]);
#pragma unroll
    for (int o = 1; o < 64; o <<= 1) { const float v = __shfl_up(gcs, o); if (lane >= o) gcs += v; }
    const float gl = __shfl(gcs, 63);
    if (lane == 0) ((float*)(ws + WS_EGL))[cid] = __expf(gl);
    const float wcoef = beta * __expf(gcs), kdcoef = __expf(gl - gcs), qcoef = __expf(gcs);
    {
        bf16x8 kcol[4][2];
#pragma unroll
        for (int ct = 0; ct < 4; ++ct)
#pragma unroll
            for (int kc = 0; kc < 2; ++kc) kcol[ct][kc] = *(const bf16x8*)(KN + (16 * ct + r) * 64 + 32 * kc + 8 * q4);
        float gj[4];
#pragma unroll
        for (int ct = 0; ct < 4; ++ct) gj[ct] = __shfl(gcs, 16 * ct + r);
#pragma unroll 1
        for (int rt = 0; rt < 4; ++rt) {
            bf16x8 krow[2], qrow[2];
#pragma unroll
            for (int kc = 0; kc < 2; ++kc) { krow[kc] = *(const bf16x8*)(KN + (16 * rt + r) * 64 + 32 * kc + 8 * q4); qrow[kc] = *(const bf16x8*)(QN + (16 * rt + r) * 64 + 32 * kc + 8 * q4); }
            float gi[4], bi[4];
#pragma unroll
            for (int jj = 0; jj < 4; ++jj) { gi[jj] = __shfl(gcs, 16 * rt + 4 * q4 + jj); bi[jj] = __shfl(beta, 16 * rt + 4 * q4 + jj); }
#pragma unroll
            for (int ct = 0; ct < 4; ++ct) {
                f32x4 a = (f32x4){0.f, 0.f, 0.f, 0.f}, qa = (f32x4){0.f, 0.f, 0.f, 0.f};
                if (ct <= rt) { a = MFMA16(krow[0], kcol[ct][0], a); a = MFMA16(krow[1], kcol[ct][1], a); qa = MFMA16(qrow[0], kcol[ct][0], qa); qa = MFMA16(qrow[1], kcol[ct][1], qa); }
#pragma unroll
                for (int jj = 0; jj < 4; ++jj) { const int i = 16 * rt + 4 * q4 + jj, j = 16 * ct + r;
                    const float dec = (j <= i) ? __expf(gi[jj] - gj[ct]) : 0.f;
                    Aw[i * 64 + j] = (j < i) ? a[jj] * bi[jj] * dec : 0.f;
                    QKM[i * 64 + j] = f2bf(qa[jj] * dec); }
            }
        }
    }
    asm volatile("s_waitcnt lgkmcnt(0)" ::: "memory");
    __builtin_amdgcn_wave_barrier();
    float arow[64];
#pragma unroll
    for (int j4 = 0; j4 < 16; ++j4) { const f32x4 a4 = *(const LAS f32x4*)(Aw + lane * 64 + 4 * j4); arow[4 * j4] = a4[0]; arow[4 * j4 + 1] = a4[1]; arow[4 * j4 + 2] = a4[2]; arow[4 * j4 + 3] = a4[3]; }
    asm volatile("s_waitcnt lgkmcnt(0)" ::: "memory");
    __builtin_amdgcn_wave_barrier();
    typedef float f32x2_ __attribute__((ext_vector_type(2)));
    const int crow = lane >> 3, ccol = (lane & 7) * 8;
#define G2_LOADPUT(SRC) do { u32x4 tch[8]; _Pragma("unroll") for (int k = 0; k < 8; ++k) tch[k] = *(const u32x4*)((SRC) + (crow + 8 * k) * 64 + ccol); \
        _Pragma("unroll") for (int k = 0; k < 8; ++k) { const unsigned w_[4] = {tch[k].x, tch[k].y, tch[k].z, tch[k].w}; \
            _Pragma("unroll") for (int e = 0; e < 8; ++e) Aw[(crow + 8 * k) * 65 + ccol + e] = (e & 1) ? __uint_as_float(w_[e >> 1] & 0xffff0000u) : __uint_as_float(w_[e >> 1] << 16); \
            asm volatile("" ::: "memory"); } } while (0)
#define G2_SOLVE(rowc) do { _Pragma("unroll 1") for (int c0 = 0; c0 < 64; c0 += 4) { \
            f32x2_ xa = (f32x2_){Aw[lane * 65 + c0] * (rowc), Aw[lane * 65 + c0 + 1] * (rowc)}, xb = (f32x2_){Aw[lane * 65 + c0 + 2] * (rowc), Aw[lane * 65 + c0 + 3] * (rowc)}; \
            _Pragma("unroll") for (int j = 0; j < 63; ++j) { const f32x2_ sa = (f32x2_){RDLANE(xa.x, j), RDLANE(xa.y, j)}, sb = (f32x2_){RDLANE(xb.x, j), RDLANE(xb.y, j)}; \
                const f32x2_ aj = (f32x2_){arow[j], arow[j]}; xa = __builtin_elementwise_fma(-aj, sa, xa); xb = __builtin_elementwise_fma(-aj, sb, xb); } \
            Aw[lane * 65 + c0] = xa.x; Aw[lane * 65 + c0 + 1] = xa.y; Aw[lane * 65 + c0 + 2] = xb.x; Aw[lane * 65 + c0 + 3] = xb.y; } } while (0)
#define G2_GET(DST) do { _Pragma("unroll") for (int k = 0; k < 8; ++k) { const LAS float* t_ = Aw + (crow + 8 * k) * 65 + ccol; u32x4 w_; \
            w_.x = cvt_pk_bf16(t_[0], t_[1]); w_.y = cvt_pk_bf16(t_[2], t_[3]); w_.z = cvt_pk_bf16(t_[4], t_[5]); w_.w = cvt_pk_bf16(t_[6], t_[7]); *(u32x4*)((DST) + (crow + 8 * k) * 64 + ccol) = w_; \
            if (k & 1) asm volatile("" ::: "memory"); } } while (0)
#define G2_SYNC() do { asm volatile("s_waitcnt lgkmcnt(0)" ::: "memory"); __builtin_amdgcn_wave_barrier(); } while (0)
#pragma unroll 1
    for (int pass = 0; pass < 2; ++pass) {
        bf16_t* RX = pass == 0 ? VB : KN;
        G2_LOADPUT(RX);
        G2_SYNC();
        if (pass == 1) {
#pragma unroll 2
            for (int i8 = 0; i8 < 8; ++i8) { unsigned kd[4];
#pragma unroll
                for (int e = 0; e < 8; ++e) { const int i = 8 * i8 + e; const unsigned v = (unsigned)f2bf(Aw[i * 65 + lane] * RDLANE(kdcoef, i));
                    if (e & 1) kd[e >> 1] |= v << 16; else kd[e >> 1] = v; }
                u32x4 w; w.x = kd[0]; w.y = kd[1]; w.z = kd[2]; w.w = kd[3]; *(u32x4*)(KDT + lane * 64 + 8 * i8) = w; }
            G2_SYNC();
        }
        const float rowc = pass == 0 ? 1.f : wcoef;
        G2_SOLVE(rowc);
        G2_SYNC();
        G2_GET(RX);
        G2_SYNC();
    }
    { u32x4 tch[8];
#pragma unroll
      for (int k = 0; k < 8; ++k) tch[k] = *(const u32x4*)(QN + (crow + 8 * k) * 64 + ccol);
#pragma unroll
      for (int k = 0; k < 8; ++k) { const float qc = __shfl(qcoef, crow + 8 * k); const unsigned w_[4] = {tch[k].x, tch[k].y, tch[k].z, tch[k].w}; u32x4 o_;
        o_.x = cvt_pk_bf16(__uint_as_float(w_[0] << 16) * qc, __uint_as_float(w_[0] & 0xffff0000u) * qc); o_.y = cvt_pk_bf16(__uint_as_float(w_[1] << 16) * qc, __uint_as_float(w_[1] & 0xffff0000u) * qc);
        o_.z = cvt_pk_bf16(__uint_as_float(w_[2] << 16) * qc, __uint_as_float(w_[2] & 0xffff0000u) * qc); o_.w = cvt_pk_bf16(__uint_as_float(w_[3] << 16) * qc, __uint_as_float(w_[3] & 0xffff0000u) * qc);
        *(u32x4*)(QN + (crow + 8 * k) * 64 + ccol) = o_; } }
    G2_SYNC();
#undef G2_LOADPUT
#undef G2_SOLVE
#undef G2_GET
#undef G2_SYNC
}
constexpr int GC_OB = 0, GC_OP = 34816, GC_OPSZ = 46080, GC_TILE = 9216;
__device__ void gdn_chain(const Params& p, unsigned char* ldsg, int bh) {
    unsigned char* ws = p.ws;
    LAS unsigned char* lds = (LAS unsigned char*)ldsg;
    const int tid = opaque_tid(), lane = tid & 63, wid = __builtin_amdgcn_readfirstlane(tid >> 6), r = lane & 15, q4 = lane >> 4, ct = wid & 3;
    const int h = bh >> 4, b = bh & 15;
    const bf16_t* __restrict__ HB = (const bf16_t*)(ws + WS_HB); const float* __restrict__ gnw = p.in[16];
    LAS float* obuf = (LAS float*)(lds + GC_OB);
    f32x4 S[4];
#pragma unroll
    for (int rt = 0; rt < 4; ++rt) S[rt] = (f32x4){0.f, 0.f, 0.f, 0.f};
    const bf16_t* __restrict__ zb = HB + ((size_t)((40 + h) * 16 + b) * SQ) * 64;
    bf16_t* __restrict__ mix = (bf16_t*)(ws + WS_ACT) + (size_t)b * SQ * 1024 + 512 + h * 64;
    const float* __restrict__ EGLb = (const float*)(ws + WS_EGL) + bh * 64;
    const int ltid = tid - 256;
    u32x4 lr[10];
#define GC_LOAD(n) do { _Pragma("unroll") for (int i = 0; i < 10; ++i) { const int e = ltid + 256 * i, tile = e >> 9, row = (e >> 3) & 63, ch = e & 7; \
        const size_t toff = tile == 0 ? WS_KN : tile == 1 ? WS_QN : tile == 2 ? WS_QKM : tile == 3 ? WS_KDT : WS_VB; \
        lr[i] = *(const u32x4*)((const bf16_t*)(ws + toff) + ((size_t)bh * 64 + (n)) * 4096 + row * 64 + ch * 8); } } while (0)
#define GC_STORE(n) do { _Pragma("unroll") for (int i = 0; i < 10; ++i) { const int e = ltid + 256 * i, tile = e >> 9, row = (e >> 3) & 63, ch = e & 7; \
        *(LAS u32x4*)(lds + GC_OP + ((n) & 1) * GC_OPSZ + tile * GC_TILE + row * 144 + ch * 16) = lr[i]; } } while (0)
#define LDP(tile, row, kc) __builtin_bit_cast(bf16x8, (u32x4){ ((const LAS u32x2*)(opb + (tile) * GC_TILE + (row) * 144 + (32 * (kc) + 4 * q4) * 2))[0].x, ((const LAS u32x2*)(opb + (tile) * GC_TILE + (row) * 144 + (32 * (kc) + 4 * q4) * 2))[0].y, \
                                                        ((const LAS u32x2*)(opb + (tile) * GC_TILE + (row) * 144 + (32 * (kc) + 16 + 4 * q4) * 2))[0].x, ((const LAS u32x2*)(opb + (tile) * GC_TILE + (row) * 144 + (32 * (kc) + 16 + 4 * q4) * 2))[0].y })
    __syncthreads();
    float egl = 0.f;
    if (wid >= 4) { GC_LOAD(0); GC_STORE(0); GC_LOAD(1); } else egl = EGLb[0];
    __syncthreads();
#pragma unroll 1
    for (int cc = 0; cc <= 64; ++cc) {
        if (wid < 4) {
            if (cc < 64) {
                LAS float* ob = obuf + (cc & 1) * 64 * 68;
                const LAS unsigned char* opb = lds + GC_OP + (cc & 1) * GC_OPSZ;
                const float egl_c = egl; if (cc < 63) egl = EGLb[cc + 1];
                bf16x8 sb[2], vb[2];
#pragma unroll
                for (int kc = 0; kc < 2; ++kc) { u32x4 pk; pk.x = cvt_pk_bf16(S[2 * kc][0], S[2 * kc][1]); pk.y = cvt_pk_bf16(S[2 * kc][2], S[2 * kc][3]); pk.z = cvt_pk_bf16(S[2 * kc + 1][0], S[2 * kc + 1][1]); pk.w = cvt_pk_bf16(S[2 * kc + 1][2], S[2 * kc + 1][3]); sb[kc] = __builtin_bit_cast(bf16x8, pk); }
                f32x4 vn[4];
#pragma unroll
                for (int rt = 0; rt < 4; ++rt) {
                    f32x4 a = (f32x4){0.f, 0.f, 0.f, 0.f};
                    a = MFMA16(LDP(0, 16 * rt + r, 0), sb[0], a); a = MFMA16(LDP(0, 16 * rt + r, 1), sb[1], a);
#pragma unroll
                    for (int jj = 0; jj < 4; ++jj) vn[rt][jj] = bf2f(*(const LAS bf16_t*)(opb + 4 * GC_TILE + (16 * rt + 4 * q4 + jj) * 144 + (16 * ct + r) * 2)) - a[jj];
                }
#pragma unroll
                for (int kc = 0; kc < 2; ++kc) { u32x4 pk; pk.x = cvt_pk_bf16(vn[2 * kc][0], vn[2 * kc][1]); pk.y = cvt_pk_bf16(vn[2 * kc][2], vn[2 * kc][3]); pk.z = cvt_pk_bf16(vn[2 * kc + 1][0], vn[2 * kc + 1][1]); pk.w = cvt_pk_bf16(vn[2 * kc + 1][2], vn[2 * kc + 1][3]); vb[kc] = __builtin_bit_cast(bf16x8, pk); }
#pragma unroll
                for (int rt = 0; rt < 4; ++rt) {
                    f32x4 a = (f32x4){0.f, 0.f, 0.f, 0.f};
                    a = MFMA16(LDP(1, 16 * rt + r, 0), sb[0], a); a = MFMA16(LDP(1, 16 * rt + r, 1), sb[1], a);
                    a = MFMA16(LDP(2, 16 * rt + r, 0), vb[0], a); a = MFMA16(LDP(2, 16 * rt + r, 1), vb[1], a);
#pragma unroll
                    for (int jj = 0; jj < 4; ++jj) ob[(16 * rt + 4 * q4 + jj) * 68 + 16 * ct + r] = a[jj];
                }
#pragma unroll
                for (int rt = 0; rt < 4; ++rt) {
                    f32x4 a = S[rt] * egl_c;
                    a = MFMA16(LDP(3, 16 * rt + r, 0), vb[0], a); a = MFMA16(LDP(3, 16 * rt + r, 1), vb[1], a);
                    S[rt] = a;
                }
            }
        } else {
            if (cc + 1 < 64) GC_STORE(cc + 1);
            if (cc + 2 < 64) GC_LOAD(cc + 2);
            if (cc >= 1) {
                const LAS float* ob = obuf + ((cc - 1) & 1) * 64 * 68;
                const int row = 16 * (wid - 4) + (lane >> 2), qd = lane & 3, s = (cc - 1) * 64 + row;
                const u32x4 z0 = *(const u32x4*)(zb + (size_t)s * 64 + 16 * qd), z1 = *(const u32x4*)(zb + (size_t)s * 64 + 16 * qd + 8);
                f32x4 v[4]; float ss = 0.f;
#pragma unroll
                for (int i = 0; i < 4; ++i) { v[i] = *(const LAS f32x4*)(ob + row * 68 + 16 * qd + 4 * i); ss += v[i][0] * v[i][0] + v[i][1] * v[i][1] + v[i][2] * v[i][2] + v[i][3] * v[i][3]; }
                ss += __shfl_xor(ss, 1); ss += __shfl_xor(ss, 2);
                const float rstd = rsqrtf(ss * (1.f / 64.f) + 1e-6f);
                const unsigned zw[8] = {z0.x, z0.y, z0.z, z0.w, z1.x, z1.y, z1.z, z1.w};
                unsigned ow[8];
#pragma unroll
                for (int i = 0; i < 8; ++i) { const float za = bf2f((bf16_t)(zw[i] & 0xffff)), zc = bf2f((bf16_t)(zw[i] >> 16));
                    const float a = v[i >> 1][(i & 1) * 2] * rstd * gnw[16 * qd + 2 * i] * siluf_(za), c = v[i >> 1][(i & 1) * 2 + 1] * rstd * gnw[16 * qd + 2 * i + 1] * siluf_(zc);
                    ow[i] = cvt_pk_bf16(a, c); }
                u32x4 w0, w1; w0.x = ow[0]; w0.y = ow[1]; w0.z = ow[2]; w0.w = ow[3]; w1.x = ow[4]; w1.y = ow[5]; w1.z = ow[6]; w1.w = ow[7];
                *(u32x4*)(mix + (size_t)s * 1024 + 16 * qd) = w0; *(u32x4*)(mix + (size_t)s * 1024 + 16 * qd + 8) = w1;
            }
        }
        __syncthreads();
    }
#undef LDP
#undef GC_LOAD
#undef GC_STORE
}
__device__ void cmp_stage2(const Params& p, unsigned char* ldsg) {
    unsigned char* ws = p.ws;
    const int tid = opaque_tid(), lane = tid & 63, wid = __builtin_amdgcn_readfirstlane(tid >> 6), G = gridDim.x;
    float* w2s = (float*)ldsg;
    for (int e = tid; e < 2 * 128 * 64; e += 512) w2s[e] = (e < 8192) ? p.in[9][e] : p.in[12][e - 8192];
    __syncthreads();
    const bf16_t* HID = (const bf16_t*)(ws + WS_HID); bf16_t* KC = (bf16_t*)(ws + WS_KC); bf16_t* VCT = (bf16_t*)(ws + WS_VCT);
    for (int r8 = blockIdx.x * 8 + wid; r8 < 2048; r8 += G * 8) {
        const int row0 = r8 * 8, isv = row0 >> 13, hb = (row0 >> 8) & 31, n0 = row0 & 255;
        const float* w = w2s + isv * 8192;
        float acc[8]; float h0[8], h1[8];
#pragma unroll
        for (int k = 0; k < 8; ++k) { const bf16_t* hr = HID + (size_t)(row0 + k) * 128; h0[k] = bf2f(hr[lane]); h1[k] = bf2f(hr[64 + lane]); acc[k] = 0.f; }
#pragma unroll 4
        for (int cc = 0; cc < 64; ++cc) { const float wa = w[cc * 64 + lane], wb = w[(64 + cc) * 64 + lane];
#pragma unroll
            for (int k = 0; k < 8; ++k) acc[k] += RDLANE(h0[k], cc) * wa + RDLANE(h1[k], cc) * wb; }
        if (n0 == 248) acc[7] = 0.f;
        if (!isv) {
#pragma unroll
            for (int k = 0; k < 8; ++k) KC[((size_t)hb * 256 + n0 + k) * 64 + lane] = f2bf(acc[k]);
        } else { u32x4 wv; wv.x = cvt_pk_bf16(acc[0], acc[1]); wv.y = cvt_pk_bf16(acc[2], acc[3]); wv.z = cvt_pk_bf16(acc[4], acc[5]); wv.w = cvt_pk_bf16(acc[6], acc[7]);
            *(u32x4*)(VCT + ((size_t)hb * 64 + lane) * 256 + n0) = wv; }
    }
    __syncthreads();
}
__device__ void sc_conv(const Params& p) {
    unsigned char* ws = p.ws;
    const bf16_t* __restrict__ SC = (const bf16_t*)(ws + WS_SC); bf16_t* __restrict__ Y = (bf16_t*)(ws + WS_ACT); const float* __restrict__ cw = p.in[19];
#pragma unroll 4
    for (size_t e = (size_t)blockIdx.x * 512 + opaque_tid(); e < (size_t)T_ * 128; e += (size_t)gridDim.x * 512) {
        const int t = (int)(e >> 7), c8 = (int)(e & 127) * 8, s = t & 4095;
        float acc[8];
#pragma unroll
        for (int i = 0; i < 8; ++i) acc[i] = 0.f;
#pragma unroll
        for (int j = 0; j < 3; ++j) { const int d = 2 - j; if (s - d >= 0) {
                const u32x4 cg = *(const u32x4*)(SC + (size_t)(t - d) * 3072 + 1024 + c8), uu = *(const u32x4*)(SC + (size_t)(t - d) * 3072 + 2048 + c8);
                const unsigned cgw[4] = {cg.x, cg.y, cg.z, cg.w}, uw[4] = {uu.x, uu.y, uu.z, uu.w};
#pragma unroll
                for (int i = 0; i < 8; ++i) { const float cv = bf2f((bf16_t)((cgw[i >> 1] >> ((i & 1) * 16)) & 0xffff)), uv = bf2f((bf16_t)((uw[i >> 1] >> ((i & 1) * 16)) & 0xffff)); acc[i] += cw[j * 1024 + c8 + i] * bf2f(f2bf(cv * uv)); } } }
        const u32x4 bg = *(const u32x4*)(SC + (size_t)t * 3072 + c8); const unsigned bw[4] = {bg.x, bg.y, bg.z, bg.w};
        u32x4 w; unsigned ow[4];
#pragma unroll
        for (int i = 0; i < 4; ++i) { const float b0 = bf2f((bf16_t)(bw[i] & 0xffff)), b1 = bf2f((bf16_t)(bw[i] >> 16)); ow[i] = cvt_pk_bf16(b0 * acc[2 * i], b1 * acc[2 * i + 1]); }
        w.x = ow[0]; w.y = ow[1]; w.z = ow[2]; w.w = ow[3];
        *(u32x4*)(Y + (size_t)t * 1024 + c8) = w;
    }
}
__device__ void final_norm(const Params& p) {
    const int lane = opaque_tid() & 63, gw = blockIdx.x * 8 + __builtin_amdgcn_readfirstlane(opaque_tid() >> 6), nw = gridDim.x * 8; const float* w = p.in[27];
    const float* ssq = (const float*)(p.ws + WS_SSQ) + (size_t)5 * T_; const bf16_t* __restrict__ XS = (const bf16_t*)(p.ws + WS_ACT2);
    f32x4 wv[4];
#pragma unroll
    for (int i = 0; i < 4; ++i) wv[i] = *(const f32x4*)(w + i * 256 + lane * 4);
    for (int r = gw; r < T_; r += 2 * nw) {
        const int r2 = r + nw;
        const float ra = rsqrtf(ssq[r] * (1.f / 1024.f) + 1e-6f), rb = rsqrtf(ssq[r2] * (1.f / 1024.f) + 1e-6f);
        u32x2 va[4], vb[4];
#pragma unroll
        for (int i = 0; i < 4; ++i) { va[i] = *(const u32x2*)(XS + (size_t)r * 1024 + i * 256 + lane * 4); vb[i] = *(const u32x2*)(XS + (size_t)r2 * 1024 + i * 256 + lane * 4); }
#pragma unroll
        for (int i = 0; i < 4; ++i) {
            const f32x4 xa = (f32x4){__uint_as_float(va[i].x << 16), __uint_as_float(va[i].x & 0xffff0000u), __uint_as_float(va[i].y << 16), __uint_as_float(va[i].y & 0xffff0000u)};
            const f32x4 xb = (f32x4){__uint_as_float(vb[i].x << 16), __uint_as_float(vb[i].x & 0xffff0000u), __uint_as_float(vb[i].y << 16), __uint_as_float(vb[i].y & 0xffff0000u)};
            *(f32x4*)(p.out + (size_t)r * 1024 + i * 256 + lane * 4) = xa * ra * wv[i]; *(f32x4*)(p.out + (size_t)r2 * 1024 + i * 256 + lane * 4) = xb * rb * wv[i]; }
    }
}
__device__ void rope_pass(const Params& p) {
    unsigned char* ws = p.ws; bf16_t* HB = (bf16_t*)(ws + WS_HB); const float* __restrict__ COS = (const float*)(ws + WS_COS); const float* __restrict__ SIN = (const float*)(ws + WS_SIN);
    const size_t total = (size_t)12 * T_ * 4, stride = (size_t)gridDim.x * 512;
#pragma unroll 1
    for (size_t e0 = (size_t)blockIdx.x * 512 + opaque_tid(); e0 < total; e0 += 4 * stride) {
        u32x4 a[4], bq[4]; f32x4 c0[4], c1[4], s0[4], s1[4]; bf16_t* ptr[4]; float qs[4]; bool ok[4];
#pragma unroll
        for (int k = 0; k < 4; ++k) { const size_t e = e0 + k * stride; ok[k] = e < total; const size_t ee = ok[k] ? e : e0;
            const int ch = (int)(ee & 3); const size_t row = ee >> 2; const int hi = (int)(row >> 16), tokr = (int)(row & 65535);
            const int Hd = hi < 8 ? hi : hi + 4; qs[k] = hi < 8 ? 0.125f * LOG2E : 1.f;
            ptr[k] = HB + ((size_t)Hd * T_ + tokr) * 64 + ch * 8;
            a[k] = *(const u32x4*)ptr[k]; bq[k] = *(const u32x4*)(ptr[k] + 32);
            c0[k] = *(const f32x4*)(COS + (size_t)tokr * 32 + ch * 8); c1[k] = *(const f32x4*)(COS + (size_t)tokr * 32 + ch * 8 + 4);
            s0[k] = *(const f32x4*)(SIN + (size_t)tokr * 32 + ch * 8); s1[k] = *(const f32x4*)(SIN + (size_t)tokr * 32 + ch * 8 + 4); }
#pragma unroll
        for (int k = 0; k < 4; ++k) {
            const unsigned aw[4] = {a[k].x, a[k].y, a[k].z, a[k].w}, bw[4] = {bq[k].x, bq[k].y, bq[k].z, bq[k].w};
            const float cw8[8] = {c0[k][0], c0[k][1], c0[k][2], c0[k][3], c1[k][0], c1[k][1], c1[k][2], c1[k][3]}, sw8[8] = {s0[k][0], s0[k][1], s0[k][2], s0[k][3], s1[k][0], s1[k][1], s1[k][2], s1[k][3]};
            float o1[8], o2[8];
#pragma unroll
            for (int i = 0; i < 8; ++i) { const float x1 = bf2f((bf16_t)((aw[i >> 1] >> ((i & 1) * 16)) & 0xffff)), x2 = bf2f((bf16_t)((bw[i >> 1] >> ((i & 1) * 16)) & 0xffff));
                o1[i] = (x1 * cw8[i] - x2 * sw8[i]) * qs[k]; o2[i] = (x2 * cw8[i] + x1 * sw8[i]) * qs[k]; }
            u32x4 wa, wb; wa.x = cvt_pk_bf16(o1[0], o1[1]); wa.y = cvt_pk_bf16(o1[2], o1[3]); wa.z = cvt_pk_bf16(o1[4], o1[5]); wa.w = cvt_pk_bf16(o1[6], o1[7]);
            wb.x = cvt_pk_bf16(o2[0], o2[1]); wb.y = cvt_pk_bf16(o2[2], o2[3]); wb.z = cvt_pk_bf16(o2[4], o2[5]); wb.w = cvt_pk_bf16(o2[6], o2[7]);
            if (ok[k]) { *(u32x4*)ptr[k] = wa; *(u32x4*)(ptr[k] + 32) = wb; }
        }
    }
}
constexpr int NPHASE = 26;
template <int PH>
__device__ __forceinline__ void run_phase(const Params& p, unsigned char* lds) {
    unsigned char* ws = p.ws;
    const int G = gridDim.x, bid = blockIdx.x, tid = opaque_tid(), lane = tid & 63, wid = __builtin_amdgcn_readfirstlane(tid >> 6);
    const int gw = bid * 8 + wid, nw = G * 8;
    LAS unsigned char* ldsl = (LAS unsigned char*)lds;
    bf16_t* ACT = (bf16_t*)(ws + WS_ACT);
    constexpr int layer = PH >= 14 ? 1 : 0;
    float* SSQ = (float*)(ws + WS_SSQ);
#define GEMM_RUN(EPI, E, Aptr, Bptr, M_, N_, K_, lda_, rot) do { pg8::Gemm g_{(const bf16_t*)(Aptr), (const bf16_t*)(Bptr), (M_), (N_), (K_), (lda_)}; pg8::StaticOrder S_; S_.init((M_), (N_), G, (bid + (rot)) % G); \
        pg8::gemm_phase<EPI>(ldsl, g_, S_, E); } while (0)
    if constexpr (PH == 0) phase_prep(p, lds);
    else if constexpr (PH == 1) {
        { pg8::EpiInproj E{(bf16_t*)(ws + WS_HB), (float*)(ws + WS_SM)};
          GEMM_RUN(pg8::EpiInproj, E, ACT, ws + WS_WIN, T_, 3328, 1024, 1024, 0); }
        { pg8::EpiBf16 E{(bf16_t*)(ws + WS_VT), T_, 1.f, 0, nullptr}; GEMM_RUN(pg8::EpiBf16, E, ws + WS_WVT, ACT, 256, T_, 1024, 1024, 0); }
        for (int l = 0; l < 2; ++l) {
            { pg8::EpiBf16 E{(bf16_t*)(ws + WS_KMEM) + (size_t)l * 4096 * 512, 512, 1.f, 0, nullptr}; GEMM_RUN(pg8::EpiBf16, E, ws + WS_MEMN, (bf16_t*)(ws + WS_WKM) + (size_t)l * 512 * 1024, 4096, 512, 1024, 1024, 64 * l); }
            { pg8::EpiBf16 E{(bf16_t*)(ws + WS_VMT) + (size_t)l * 512 * 4096, 4096, 1.f, 0, nullptr}; GEMM_RUN(pg8::EpiBf16, E, (bf16_t*)(ws + WS_WVM) + (size_t)l * 512 * 1024, ws + WS_MEMN, 512, 4096, 1024, 1024, 64 * l + 32); }
        }
    } else if constexpr (PH == 2) {
        { pg8::EpiCmp1 E{(bf16_t*)(ws + WS_HID), (const float*)(ws + WS_BIAS1)};
          GEMM_RUN(pg8::EpiCmp1, E, (bf16_t*)(ws + WS_HB) + (size_t)8 * 16 * SQ * 64, ws + WS_WCMP1, 16384, 256, 2048, 1024, 0); }
        gdn_g1(p, (gw + 64 * 8) % nw, nw, lane);
        rope_pass(p);
    } else if constexpr (PH == 3) {
        cmp_stage2(p, lds);
        LAS float* Aw = (LAS float*)(ldsl + wid * 16640);
        for (int cid = gw; cid < 8192; cid += nw) gdn_g2(p, Aw, cid, lane);
    } else if constexpr (PH == 4) {
    } else if constexpr (PH == 5) {
        for (int e = bid * 512 + tid; e < 6 * T_; e += G * 512) SSQ[e] = 0.f;
        if (bid < 128) gdn_chain(p, lds, bid);
        unsigned* ctr = (unsigned*)(ws + WS_CTL);
        LAS int* s_item = (LAS int*)(ldsl + LDS_BYTES - 16);
        for (;;) {
            if (tid == 0) *s_item = (int)atomicAdd(ctr, 1u);
            __syncthreads();
            const int item = __builtin_amdgcn_readfirstlane(*s_item);
            __syncthreads();
            if (item >= 4096) break;
            nsa_item(p, lds, item);
        }
    } else if constexpr (PH == 6) { pg8::EpiResid<false> E{p.in[0], 1024, (bf16_t*)(ws + WS_ACT2), SSQ}; GEMM_RUN(pg8::EpiResid<false>, E, ACT, ws + WS_WOUT, T_, 1024, 1024, 1024, 0); }
    else if constexpr (PH == 8 || PH == 19) { pg8::EpiBf16 E{(bf16_t*)(ws + WS_QX), 512, 0.08838834764831845f * LOG2E, 0, SSQ + (size_t)(layer ? 3 : 0) * T_}; GEMM_RUN(pg8::EpiBf16, E, ws + WS_ACT2, (bf16_t*)(ws + WS_WQ) + (size_t)layer * 512 * 1024, T_, 512, 1024, 1024, 0); }
    else if constexpr (PH == 9 || PH == 20) { for (int blk = bid; blk < 256; blk += G) xattn_block(p, lds, blk, layer); }
    else if constexpr (PH == 10 || PH == 21) { pg8::EpiResid<true> E{ws + WS_ACT2, 1024, ACT, SSQ + (size_t)(layer ? 4 : 1) * T_}; GEMM_RUN(pg8::EpiResid<true>, E, ws + WS_OX, (bf16_t*)(ws + WS_WO) + (size_t)layer * 1024 * 512, T_, 1024, 512, 512, 0); }
    else if constexpr (PH == 12 || PH == 23) { pg8::EpiBf16 E{(bf16_t*)(ws + WS_H1), 4096, 1.f, 1, SSQ + (size_t)(layer ? 4 : 1) * T_}; GEMM_RUN(pg8::EpiBf16, E, ACT, (bf16_t*)(ws + WS_W1) + (size_t)layer * 4096 * 1024, T_, 4096, 1024, 1024, 0); }
    else if constexpr (PH == 13) { pg8::EpiResid<true> E{ACT, 1024, (bf16_t*)(ws + WS_ACT2), SSQ + (size_t)2 * T_}; GEMM_RUN(pg8::EpiResid<true>, E, ws + WS_H1, (bf16_t*)(ws + WS_W2), T_, 1024, 4096, 4096, 0); }
    else if constexpr (PH == 24) { pg8::EpiResid<true> E{ACT, 1024, (bf16_t*)(ws + WS_ACT2), SSQ + (size_t)5 * T_}; GEMM_RUN(pg8::EpiResid<true>, E, ws + WS_H1, (bf16_t*)(ws + WS_W2) + (size_t)1024 * 4096, T_, 1024, 4096, 4096, 0); }
    else if constexpr (PH == 15) { pg8::EpiBf16 E{(bf16_t*)(ws + WS_SC), 3072, 1.f, 0, SSQ + (size_t)2 * T_}; GEMM_RUN(pg8::EpiBf16, E, ws + WS_ACT2, ws + WS_WSCIN, T_, 3072, 1024, 1024, 0); }
    else if constexpr (PH == 16) sc_conv(p);
    else if constexpr (PH == 17) { pg8::EpiResid<true> E{ws + WS_ACT2, 1024, (bf16_t*)(ws + WS_ACT2), SSQ + (size_t)3 * T_}; GEMM_RUN(pg8::EpiResid<true>, E, ACT, ws + WS_WSCOUT, T_, 1024, 1024, 1024, 0); }
    else if constexpr (PH == 25) final_norm(p);
#undef GEMM_RUN
}

#ifndef SINGLE_LAUNCH
#define SINGLE_LAUNCH 1
#endif
template <int PH>
__global__ void __launch_bounds__(512, 2) phase_kernel(Params p) {
    extern __shared__ __attribute__((aligned(16))) unsigned char lds[];
    run_phase<PH>(p, lds);
}

#define XB_TMO      128
#define XB_XCNT(j)  (256  + 64 * (j))
#define XB_XSUB(j)  (1280 + 64 * (j))
#define XB_XGEN(j)  (2304 + 64 * (j))
#define XB_TOP      3328
#define XB_TOPGEN   3392
#define XCD_BAR_WORDS 3456
#define XB_SPIN_CAP (1u << 18)
__device__ __forceinline__ unsigned xb_ld(unsigned* p)              { return __hip_atomic_load(p, __ATOMIC_RELAXED, __HIP_MEMORY_SCOPE_AGENT); }
__device__ __forceinline__ unsigned xb_add(unsigned* p, unsigned v) { return __hip_atomic_fetch_add(p, v, __ATOMIC_RELAXED, __HIP_MEMORY_SCOPE_AGENT); }
__device__ __forceinline__ unsigned xb_xcc_id() { return (unsigned)__builtin_amdgcn_s_getreg((3 << 11) | 20) & 0xFu; }
#define XB_SPIN(cond, bar) do { while (cond) { __builtin_amdgcn_s_sleep(1); } } while (0)
struct XcdBarrier { unsigned* bar; unsigned x; volatile LAS unsigned* st; };
__device__ __forceinline__ XcdBarrier xcd_barrier_post(unsigned* bar, volatile LAS unsigned* st) {
    XcdBarrier b; b.bar = bar; b.x = xb_xcc_id(); b.st = st;
    if (threadIdx.x == 0) (void)xb_add(&bar[XB_XCNT(b.x)], 1u);
    return b;
}
__device__ __forceinline__ void xcd_barrier_complete(unsigned* bar, unsigned x, unsigned& nloc, unsigned& nx) {
    const unsigned G = gridDim.x * gridDim.y * gridDim.z;
    unsigned sum, cnt, mine, sp = 0u;
    for (;;) {
        sum = 0u; cnt = 0u; mine = 0u;
#pragma unroll
        for (unsigned j = 0; j < 16; ++j) { const unsigned c = xb_ld(&bar[XB_XCNT(j)]); sum += c; cnt += (c > 0u) ? 1u : 0u; mine = (j == x) ? c : mine; }
        if (sum == G) break;
        __builtin_amdgcn_s_sleep(1);
        if ((++sp & 255u) == 0u) { if (xb_ld(&bar[XB_TMO])) break; if (sp > XB_SPIN_CAP) { atomicAdd(&bar[XB_TMO], 1u); break; } }
    }
    nloc = mine > 0u ? mine : 1u; nx = cnt > 0u ? cnt : 1u;
}
__device__ __forceinline__ void xcd_barrier(unsigned* bar_, volatile LAS unsigned* st_) {
    XcdBarrier b; b.bar = bar_; b.x = xb_xcc_id(); b.st = st_;
    asm volatile("s_waitcnt vmcnt(0)" ::: "memory");
    __syncthreads();
    if (threadIdx.x == 0) {
        unsigned* bar = b.bar;
        __builtin_amdgcn_s_waitcnt(0);
        unsigned nloc = b.st[0], nx = b.st[1];
        const unsigned old = xb_add(&bar[XB_XSUB(b.x)], 1u);
        const unsigned gen = old / nloc;
        if (old + 1u == (gen + 1u) * nloc) {
            __builtin_amdgcn_fence(__ATOMIC_RELEASE, "agent");
            asm volatile("s_waitcnt vmcnt(0)" ::: "memory");
            const unsigned og = xb_add(&bar[XB_TOP], 1u);
            const unsigned tg = og / nx;
            if (og + 1u == (tg + 1u) * nx) xb_add(&bar[XB_TOPGEN], 1u);
            else XB_SPIN(xb_ld(&bar[XB_TOPGEN]) == tg, bar);
            __builtin_amdgcn_fence(__ATOMIC_ACQUIRE, "agent");
            xb_add(&bar[XB_XGEN(b.x)], 1u);
            asm volatile("s_waitcnt vmcnt(0)" ::: "memory");
        } else {
            XB_SPIN(xb_ld(&bar[XB_XGEN(b.x)]) == gen, bar);
            __builtin_amdgcn_fence(__ATOMIC_ACQUIRE, "agent");
            asm volatile("s_waitcnt vmcnt(0)" ::: "memory");
        }
    }
    __syncthreads();
}
constexpr size_t WS_XBAR = 65536;

template <int LO, int HI>
__device__ __forceinline__ void run_range(const Params& p, unsigned char* lds, cg::grid_group& grid) {
    run_phase<LO>(p, lds);
    if constexpr (LO < HI) { grid.sync(); run_range<LO + 1, HI>(p, lds, grid); }
}
template <int PH>
__device__ __forceinline__ void run_all(const Params& p, unsigned char* lds, cg::grid_group& grid) {
    asm volatile("; PHASE_MARK %0" :: "n"(PH));
    run_phase<PH>(p, lds);
#ifdef PROBE_SYNCS
    if constexpr (PH == 0) { for (int q = 0; q < PROBE_SYNCS; ++q) grid.sync(); }
#endif
#ifdef PROBE_SET
    if constexpr (((PROBE_SET >> PH) & 1u) != 0u) { grid.sync(); run_phase<PH>(p, lds); }
#endif
#ifdef PROBE_LO
    if constexpr (PH == PROBE_HI) { grid.sync(); if (blockIdx.x == 0 && opaque_tid() == 0) ((unsigned*)(p.ws + WS_CTL))[0] = 0u; grid.sync(); run_range<PROBE_LO, PROBE_HI>(p, lds, grid); }
#endif
    if constexpr (PH + 1 < NPHASE) { if constexpr (PH == 0) grid.sync(); else if constexpr (PH != 4 && PH != 7 && PH != 11 && PH != 14 && PH != 18 && PH != 22) xcd_barrier((unsigned*)(p.ws + WS_XBAR), (volatile LAS unsigned*)((LAS unsigned char*)lds + LDS_BYTES - 32)); run_all<PH + 1>(p, lds, grid); }
}
__global__ void __launch_bounds__(512, 2) hybrid_fwd(Params p) {
    extern __shared__ __attribute__((aligned(16))) unsigned char lds[];
    cg::grid_group grid = cg::this_grid();
    volatile LAS unsigned* st = (volatile LAS unsigned*)((LAS unsigned char*)lds + LDS_BYTES - 32);
    if (threadIdx.x < 2) st[threadIdx.x] = 0u;
    __syncthreads();
    { const XcdBarrier b0 = xcd_barrier_post((unsigned*)(p.ws + WS_XBAR), st);
      if (threadIdx.x == 0) { unsigned nloc, nx; xcd_barrier_complete(b0.bar, b0.x, nloc, nx); st[0] = nloc; st[1] = nx; }
      __syncthreads(); }
    run_all<0>(p, lds, grid);
}
template <int PH> static void launch_phases(const Params& p, int grid, hipStream_t stream) {
    static bool attr_done = false;
    if (!attr_done) { (void)hipFuncSetAttribute((const void*)phase_kernel<PH>, hipFuncAttributeMaxDynamicSharedMemorySize, LDS_BYTES); attr_done = true; }
    hipLaunchKernelGGL(phase_kernel<PH>, dim3(grid), dim3(512), LDS_BYTES, stream, p);
    if constexpr (PH + 1 < NPHASE) launch_phases<PH + 1>(p, grid, stream);
}

extern "C" void kernel_launch(void* const* d_in, const int* in_sizes, int n_in, void* d_out, int out_size, void* d_ws, size_t ws_size, hipStream_t stream) {
    static int grid = 0;
    if (grid == 0) {
        if (n_in != 28 || ws_size < WS_END) { fprintf(stderr, "kernel_launch: unexpected n_in %d or ws_size %zu (need %zu)\n", n_in, ws_size, (size_t)WS_END); grid = -1; return; }
        int dev = 0, cus = 0;
        (void)hipGetDevice(&dev); (void)hipDeviceGetAttribute(&cus, hipDeviceAttributeMultiprocessorCount, dev);
        grid = cus;
    }
    if (grid < 0) return;
    Params p{};
    for (int i = 0; i < 28; ++i) p.in[i] = (const float*)d_in[i];
    p.out = (float*)d_out; p.ws = (unsigned char*)d_ws; p.ph_lo = 0; p.ph_hi = NPHASE;
#if SINGLE_LAUNCH
    static bool attr_done = false;
    if (!attr_done) { if (hipFuncSetAttribute((const void*)hybrid_fwd, hipFuncAttributeMaxDynamicSharedMemorySize, LDS_BYTES) != hipSuccess) fprintf(stderr, "kernel_launch: hipFuncSetAttribute failed\n"); attr_done = true; }
    (void)hipMemsetAsync((char*)d_ws + WS_XBAR, 0, 16384, stream);
    void* args[] = {&p};
    hipError_t e = hipLaunchCooperativeKernel((const void*)hybrid_fwd, dim3(grid), dim3(512), args, LDS_BYTES, stream);
    if (e != hipSuccess) fprintf(stderr, "cooperative launch failed: %s (grid %d)\n", hipGetErrorString(e), grid);
#else
    launch_phases<0>(p, grid, stream);
#endif
}
```

```cpp
#include <hip/hip_runtime.h>
#include <hip/hip_cooperative_groups.h>
#include <cstdio>
namespace cg = cooperative_groups;

#define LAS __attribute__((address_space(3)))
typedef unsigned short bf16_t;
typedef short bf16x8 __attribute__((ext_vector_type(8)));
typedef float f32x4 __attribute__((ext_vector_type(4)));
typedef unsigned u32x4 __attribute__((ext_vector_type(4)));
typedef unsigned u32x2 __attribute__((ext_vector_type(2)));
typedef unsigned long long u64;

constexpr int T_ = 65536, SQ = 4096;
constexpr size_t MiB = 1ull << 20;
constexpr size_t WS_CTL = 0, WS_BIAS1 = 4096, WS_EGL = 8192;
constexpr size_t WS_WIN = 1 * MiB, WS_WVT = 8 * MiB, WS_WCMP1 = 9 * MiB, WS_WOUT = 10 * MiB, WS_WSCIN = 12 * MiB, WS_WSCOUT = 18 * MiB;
constexpr size_t WS_WQ = 20 * MiB, WS_WKM = 22 * MiB, WS_WVM = 24 * MiB, WS_WO = 26 * MiB, WS_W1 = 28 * MiB, WS_W2 = 44 * MiB;
constexpr size_t WS_COS = 60 * MiB, WS_SIN = 68 * MiB, WS_MEMN = 76 * MiB, WS_KMEM = 84 * MiB, WS_VMT = 92 * MiB;
constexpr size_t WS_ACT = 100 * MiB, WS_VT = 228 * MiB, WS_SM = 260 * MiB, WS_HID = 276 * MiB, WS_KC = 280 * MiB, WS_VCT = 281 * MiB;
constexpr size_t WS_HB = 283 * MiB, WS_QN = 667 * MiB, WS_KN = 731 * MiB, WS_VB = 795 * MiB, WS_QKM = 859 * MiB, WS_KDT = 923 * MiB, WS_END = 987 * MiB;
constexpr size_t WS_ACT2 = WS_QKM, WS_SSQ = WS_HID;
constexpr size_t WS_H1 = WS_HB, WS_SC = WS_HB, WS_QX = WS_HB, WS_OX = WS_HB + 64 * MiB;
constexpr int LDS_BYTES = 143360;
constexpr float LOG2E = 1.4426950408889634f;

struct Params { const float* in[28]; float* out; unsigned char* ws; int ph_lo, ph_hi; };

__device__ __forceinline__ unsigned cvt_pk_bf16(float lo, float hi) { unsigned r; asm volatile("v_cvt_pk_bf16_f32 %0, %1, %2" : "=v"(r) : "v"(lo), "v"(hi)); return r; }
__device__ __forceinline__ bf16_t f2bf(float f) { return (bf16_t)(cvt_pk_bf16(f, 0.f) & 0xffffu); }
__device__ __forceinline__ float bf2f(bf16_t b) { return __uint_as_float(((unsigned)b) << 16); }
__device__ __forceinline__ float wave_sum(float v) {
#pragma unroll
    for (int o = 32; o >= 1; o >>= 1) v += __shfl_xor(v, o);
    return v; }
__device__ __forceinline__ float sigmoidf_(float x) { return __builtin_amdgcn_rcpf(1.f + __expf(-x)); }
__device__ __forceinline__ float siluf_(float x) { return x * __builtin_amdgcn_rcpf(1.f + __expf(-x)); }
__device__ __forceinline__ int opaque_tid() { int t = threadIdx.x; asm volatile("" : "+v"(t)); return t; }
#define RDLANE(v, i) __int_as_float(__builtin_amdgcn_readlane(__float_as_int(v), (i)))
#define MFMA16(a, b, c) __builtin_amdgcn_mfma_f32_16x16x32_bf16(a, b, c, 0, 0, 0)

namespace pg8 {
constexpr int BM = 256, BK = 64, HALF = 128, HTB = HALF * BK * 2, STAGE_BYTES = 8 * HTB, NXCD = 8, WGM = 8;
__device__ __forceinline__ int lds_byte(int r, int c) { const int st = (r >> 4) * 2 + (c >> 5), rr = r & 15, cc = c & 31, ob = rr * 64 + cc * 2; return st * 1024 + (ob ^ (((ob >> 9) & 1) << 5)); }
__device__ __forceinline__ void stage_rc(int b, int& R, int& C) { const int st = b / 1024, sb = b % 1024, swz = sb ^ (((sb >> 9) & 1) << 5); R = (st >> 1) * 16 + swz / 64; C = (st & 1) * 32 + (swz % 64) / 2; }
__device__ __forceinline__ int perm32(int rho) { const int n = rho >> 4, i = rho & 15; return 8 * (i >> 2) + 4 * n + (i & 3); }
struct Unit { int pm, pn; };
struct Gemm { const bf16_t* A; const bf16_t* Bt; int M, N, K, lda; };
struct StaticOrder {
    int nM, nN, nwg, G, c;
    __device__ void init(int M, int N, int G_, int c_) { nM = M / BM; nN = N / BM; nwg = nM * nN; G = G_; c = c_; }
    __device__ bool next(int i, Unit& u) const {
        const long L = (long)i * G + c; if (L >= nwg) return false;
        int wgid = (int)L; { const int q = nwg / NXCD, r = nwg % NXCD, xcd = wgid % NXCD, off = wgid / NXCD; wgid = (xcd < r ? xcd * (q + 1) : r * (q + 1) + (xcd - r) * q) + off; }
        const int nig = WGM * nN, gid = wgid / nig, fm = gid * WGM, gsz = (nM - fm) < WGM ? (nM - fm) : WGM;
        u.pm = fm + ((wgid % nig) % gsz); u.pn = (wgid % nig) / gsz; return true;
    }
};

template <class Epi>
__device__ __forceinline__ void gemm_phase(LAS unsigned char* lds, const Gemm g, const StaticOrder& S, const Epi& E) {
    const int tid = opaque_tid(), wid = __builtin_amdgcn_readfirstlane(tid >> 6), lane = tid & 63, wr = wid >> 2, wc = wid & 3, fr = lane & 15, fq = lane >> 4;
    const int K = g.K, nt = K / BK, lda = g.lda;
    unsigned voffA[2], voffB[2];
#pragma unroll
    for (int i = 0; i < 2; ++i) { int R, C; stage_rc(tid * 16 + i * 8192, R, C); const int Rb = Epi::PERM ? ((R & ~31) + perm32(R & 31)) : R;
        voffA[i] = (unsigned)(R * lda + C) * 2u; voffB[i] = (unsigned)(Rb * K + C) * 2u; }
    const size_t kstep = (size_t)(BK * 2);
    const size_t hstepA = (size_t)HALF * lda * 2, hstepB = (size_t)HALF * K * 2;
    const size_t tstepA = 2 * hstepA, tstepB = 2 * hstepB;
    const unsigned ldsw = (unsigned)wid * 1024u;
    const int aoff = lds_byte(wr * 64 + fr, fq * 8), boff = lds_byte(wc * 32 + fr, fq * 8);
#define PG8_SA(b, h) (((b) * 2 + (h)) * HTB)
#define PG8_SB(b, h) ((4 + (b) * 2 + (h)) * HTB)
#define PG8_STAGE(bufoff, gbase, voff) do { _Pragma("unroll") for (int _i = 0; _i < 2; ++_i) \
        __builtin_amdgcn_global_load_lds((const unsigned*)((const char*)(gbase) + (voff)[_i]), (LAS unsigned*)(lds + (bufoff) + ldsw + _i * 8192), 16, 0, 0); } while (0)
#define PG8_LDA(dst, b, h) do { _Pragma("unroll") for (int m = 0; m < 4; ++m) _Pragma("unroll") for (int k = 0; k < 2; ++k) dst[m][k] = *(const LAS bf16x8*)(lds + PG8_SA(b, h) + aoff + m * 2048 + k * 1024); } while (0)
#define PG8_LDB(dst, b, h) do { _Pragma("unroll") for (int n = 0; n < 2; ++n) _Pragma("unroll") for (int k = 0; k < 2; ++k) dst[n][k] = *(const LAS bf16x8*)(lds + PG8_SB(b, h) + boff + n * 2048 + k * 1024); } while (0)
#define PG8_MMA(ai, bj, At, Bt) do { __builtin_amdgcn_s_setprio(1); _Pragma("unroll") for (int m = 0; m < 4; ++m) _Pragma("unroll") for (int n = 0; n < 2; ++n) _Pragma("unroll") for (int k = 0; k < 2; ++k) \
        acc[ai][bj][m][n] = __builtin_amdgcn_mfma_f32_16x16x32_bf16(Bt[n][k], At[m][k], acc[ai][bj][m][n], 0, 0, 0); __builtin_amdgcn_s_setprio(0); } while (0)
#define PG8_WAIT_V(n) asm volatile("s_waitcnt vmcnt(" #n ")" ::: "memory")
#define PG8_WAIT_L(n) asm volatile("s_waitcnt lgkmcnt(" #n ")" ::: "memory")
#define PG8_BAR __builtin_amdgcn_s_barrier()
#define PG8_SCHED __builtin_amdgcn_sched_barrier(0)
    Unit cur, nxt; int ui = 0;
    if (!S.next(0, cur)) return;
    f32x4 acc[2][2][4][2];
#pragma unroll
    for (int a = 0; a < 2; ++a)
#pragma unroll
        for (int b = 0; b < 2; ++b)
#pragma unroll
            for (int m = 0; m < 4; ++m)
#pragma unroll
                for (int n = 0; n < 2; ++n) acc[a][b][m][n] = (f32x4){0.f, 0.f, 0.f, 0.f};
    bf16x8 At[4][2], B0[2][2], B1[2][2];
    const char* cA = (const char*)g.A + (size_t)cur.pm * tstepA; const char* cB = (const char*)g.Bt + (size_t)cur.pn * tstepB;
    PG8_STAGE(PG8_SB(0, 0), cB, voffB); PG8_STAGE(PG8_SA(0, 0), cA, voffA); PG8_STAGE(PG8_SB(0, 1), cB + hstepB, voffB); PG8_STAGE(PG8_SA(0, 1), cA + hstepA, voffA);
    if (wr == 1) PG8_BAR;
    PG8_WAIT_V(4); PG8_BAR;
    PG8_STAGE(PG8_SB(1, 0), cB + kstep, voffB); PG8_STAGE(PG8_SA(1, 0), cA + kstep, voffA); PG8_STAGE(PG8_SB(1, 1), cB + hstepB + kstep, voffB);
    PG8_WAIT_V(6); PG8_BAR;
    for (;;) {
        const bool has_next = S.next(ui + 1, nxt);
        const char* nA = has_next ? (const char*)g.A + (size_t)nxt.pm * tstepA : cA; const char* nB = has_next ? (const char*)g.Bt + (size_t)nxt.pn * tstepB : cB;
        for (int t = 0; t < nt; t += 2) {
            const bool last = (t == nt - 2);
            const char* a1 = cA + (size_t)(t + 1) * kstep;
            const char* a2 = last ? nA : cA + (size_t)(t + 2) * kstep; const char* b2 = last ? nB : cB + (size_t)(t + 2) * kstep;
            const char* a3 = a2 + kstep; const char* b3 = b2 + kstep;
            PG8_LDB(B0, 0, 0); PG8_SCHED; PG8_LDA(At, 0, 0); PG8_STAGE(PG8_SA(1, 1), a1 + hstepA, voffA);
            PG8_WAIT_L(8); PG8_BAR; PG8_WAIT_L(0); PG8_MMA(0, 0, At, B0); PG8_BAR; PG8_SCHED;
            PG8_LDB(B1, 0, 1); PG8_STAGE(PG8_SB(0, 0), b2, voffB);
            PG8_BAR; PG8_WAIT_L(0); PG8_MMA(0, 1, At, B1); PG8_BAR;
            PG8_LDA(At, 0, 1); PG8_STAGE(PG8_SA(0, 0), a2, voffA);
            PG8_BAR; PG8_WAIT_L(0); PG8_MMA(1, 0, At, B0); PG8_BAR; PG8_SCHED;
            PG8_STAGE(PG8_SB(0, 1), b2 + hstepB, voffB);
            PG8_WAIT_V(6); PG8_BAR; PG8_MMA(1, 1, At, B1); PG8_BAR;
            PG8_LDB(B0, 1, 0); PG8_SCHED; PG8_LDA(At, 1, 0); PG8_STAGE(PG8_SA(0, 1), a2 + hstepA, voffA);
            PG8_WAIT_L(8); PG8_BAR; PG8_WAIT_L(0); PG8_MMA(0, 0, At, B0); PG8_BAR; PG8_SCHED;
            PG8_LDB(B1, 1, 1); PG8_STAGE(PG8_SB(1, 0), b3, voffB);
            PG8_BAR; PG8_WAIT_L(0); PG8_MMA(0, 1, At, B1); PG8_BAR;
            PG8_LDA(At, 1, 1); PG8_STAGE(PG8_SA(1, 0), a3, voffA);
            PG8_BAR; PG8_WAIT_L(0); PG8_MMA(1, 0, At, B0); PG8_BAR; PG8_SCHED;
            PG8_STAGE(PG8_SB(1, 1), b3 + hstepB, voffB);
            PG8_WAIT_V(6); PG8_BAR; PG8_MMA(1, 1, At, B1); PG8_BAR;
        }
        E(acc, cur, wr, wc, fr, fq);
        if (!has_next) break;
#pragma unroll
        for (int a = 0; a < 2; ++a)
#pragma unroll
            for (int b = 0; b < 2; ++b)
#pragma unroll
                for (int m = 0; m < 4; ++m)
#pragma unroll
                    for (int n = 0; n < 2; ++n) acc[a][b][m][n] = (f32x4){0.f, 0.f, 0.f, 0.f};
        cur = nxt; cA = nA; cB = nB; ++ui;
    }
    PG8_WAIT_V(0);
    if (wr == 0) PG8_BAR;
    PG8_BAR;
#undef PG8_SA
#undef PG8_SB
#undef PG8_STAGE
#undef PG8_LDA
#undef PG8_LDB
#undef PG8_MMA
#undef PG8_WAIT_V
#undef PG8_WAIT_L
#undef PG8_BAR
#undef PG8_SCHED
}

struct EpiBf16 {
    static constexpr bool PERM = true;
    bf16_t* O; int ldc; float scale; int act; const float* ssq;
    __device__ __forceinline__ void operator()(const f32x4 (&acc)[2][2][4][2], const Unit& u, int wr, int wc, int fr, int fq) const {
        const int row0 = u.pm * BM + wr * 64 + fr, col0 = u.pn * BM + wc * 32 + 8 * fq;
        float rscv[2][4];
#pragma unroll
        for (int ai = 0; ai < 2; ++ai)
#pragma unroll
            for (int m = 0; m < 4; ++m) rscv[ai][m] = ssq ? ssq[row0 + ai * HALF + m * 16] : 0.f;
        asm volatile("" ::: "memory");
#pragma unroll
        for (int ai = 0; ai < 2; ++ai)
#pragma unroll
            for (int m = 0; m < 4; ++m) { bf16_t* rowp = O + (size_t)(row0 + ai * HALF + m * 16) * ldc + col0;
                const float rsc = ssq ? scale * rsqrtf(rscv[ai][m] * (1.f / 1024.f) + 1e-6f) : scale;
#pragma unroll
                for (int bj = 0; bj < 2; ++bj) { f32x4 v0 = acc[ai][bj][m][0] * rsc, v1 = acc[ai][bj][m][1] * rsc;
                    if (act == 1) {
#pragma unroll
                        for (int j = 0; j < 4; ++j) { const float a = fmaxf(v0[j], 0.f), b = fmaxf(v1[j], 0.f); v0[j] = a * a; v1[j] = b * b; } }
                    u32x4 w; w.x = cvt_pk_bf16(v0[0], v0[1]); w.y = cvt_pk_bf16(v0[2], v0[3]); w.z = cvt_pk_bf16(v1[0], v1[1]); w.w = cvt_pk_bf16(v1[2], v1[3]);
                    *(u32x4*)(rowp + bj * HALF) = w; } }
    }
};
template <bool BF>
struct EpiResid {
    static constexpr bool PERM = true;
    const void* base; int ldc; bf16_t* XB; float* ssq;
    __device__ __forceinline__ void operator()(const f32x4 (&acc)[2][2][4][2], const Unit& u, int wr, int wc, int fr, int fq) const {
        const int row0 = u.pm * BM + wr * 64 + fr, col0 = u.pn * BM + wc * 32 + 8 * fq;
#pragma unroll
        for (int ai = 0; ai < 2; ++ai) {
            f32x4 bv[4][2][2];
#pragma unroll
            for (int m = 0; m < 4; ++m)
#pragma unroll
                for (int bj = 0; bj < 2; ++bj) { const size_t o_ = (size_t)(row0 + ai * HALF + m * 16) * ldc + col0 + bj * HALF;
                    if (BF) { const u32x4 r_ = *(const u32x4*)((const bf16_t*)base + o_);
                        bv[m][bj][0] = (f32x4){__uint_as_float(r_.x << 16), __uint_as_float(r_.x & 0xffff0000u), __uint_as_float(r_.y << 16), __uint_as_float(r_.y & 0xffff0000u)};
                        bv[m][bj][1] = (f32x4){__uint_as_float(r_.z << 16), __uint_as_float(r_.z & 0xffff0000u), __uint_as_float(r_.w << 16), __uint_as_float(r_.w & 0xffff0000u)}; }
                    else { bv[m][bj][0] = *(const f32x4*)((const float*)base + o_); bv[m][bj][1] = *(const f32x4*)((const float*)base + o_ + 4); } }
            float sq[4];
#pragma unroll
            for (int m = 0; m < 4; ++m) { const size_t off = (size_t)(row0 + ai * HALF + m * 16) * ldc + col0; float s_ = 0.f;
#pragma unroll
                for (int bj = 0; bj < 2; ++bj) { const f32x4 v0 = bv[m][bj][0] + acc[ai][bj][m][0], v1 = bv[m][bj][1] + acc[ai][bj][m][1];
                    s_ += (v0[0] * v0[0] + v0[1] * v0[1]) + (v0[2] * v0[2] + v0[3] * v0[3]) + (v1[0] * v1[0] + v1[1] * v1[1]) + (v1[2] * v1[2] + v1[3] * v1[3]);
                    u32x4 w; w.x = cvt_pk_bf16(v0[0], v0[1]); w.y = cvt_pk_bf16(v0[2], v0[3]); w.z = cvt_pk_bf16(v1[0], v1[1]); w.w = cvt_pk_bf16(v1[2], v1[3]);
                    *(u32x4*)(XB + off + bj * HALF) = w; }
                sq[m] = s_; }
#pragma unroll
            for (int m = 0; m < 4; ++m) { float s_ = sq[m]; s_ += __shfl_xor(s_, 16); s_ += __shfl_xor(s_, 32); if (fq == 0) atomicAdd(ssq + row0 + ai * HALF + m * 16, s_); }
            asm volatile("" ::: "memory");
        }
    }
};
struct EpiCmp1 {
    static constexpr bool PERM = true;
    bf16_t* HID; const float* bias1;
    __device__ __forceinline__ void operator()(const f32x4 (&acc)[2][2][4][2], const Unit& u, int wr, int wc, int fr, int fq) const {
        const int isv = u.pm >= 32 ? 1 : 0; const int row0 = u.pm * BM + wr * 64 + fr, c0 = wc * 32 + 8 * fq;
        const f32x4 b0 = *(const f32x4*)(bias1 + isv * 128 + c0), b1 = *(const f32x4*)(bias1 + isv * 128 + c0 + 4);
#pragma unroll
        for (int ai = 0; ai < 2; ++ai)
#pragma unroll
            for (int m = 0; m < 4; ++m) { bf16_t* rowp = HID + (size_t)(row0 + ai * HALF + m * 16) * 128 + c0;
                f32x4 v0 = (isv ? acc[ai][1][m][0] : acc[ai][0][m][0]) + b0, v1 = (isv ? acc[ai][1][m][1] : acc[ai][0][m][1]) + b1;
#pragma unroll
                for (int j = 0; j < 4; ++j) { v0[j] = siluf_(v0[j]); v1[j] = siluf_(v1[j]); }
                u32x4 w; w.x = cvt_pk_bf16(v0[0], v0[1]); w.y = cvt_pk_bf16(v0[2], v0[3]); w.z = cvt_pk_bf16(v1[0], v1[1]); w.w = cvt_pk_bf16(v1[2], v1[3]);
                *(u32x4*)rowp = w; }
    }
};
struct EpiInproj {
    static constexpr bool PERM = true;
    bf16_t* HB; float* SM;
    __device__ __forceinline__ void operator()(const f32x4 (&acc)[2][2][4][2], const Unit& u, int wr, int wc, int fr, int fq) const {
        const int row0 = u.pm * BM + wr * 64 + fr;
        if (u.pn < 12) {
            const int wpar = wc & 1;
#pragma unroll
            for (int bj = 0; bj < 2; ++bj) {
                const int Hd = u.pn * 4 + bj * 2 + (wc >> 1);
                const unsigned off0 = (((unsigned)Hd * (unsigned)T_ + (unsigned)row0) * 64u + 32u * wpar + 8u * fq) * 2u;
#pragma unroll
                for (int ai = 0; ai < 2; ++ai)
#pragma unroll
                    for (int m = 0; m < 4; ++m) {
                        const f32x4 x1 = acc[ai][bj][m][0], x2 = acc[ai][bj][m][1];
                        u32x4 w; w.x = cvt_pk_bf16(x1[0], x1[1]); w.y = cvt_pk_bf16(x1[2], x1[3]); w.z = cvt_pk_bf16(x2[0], x2[1]); w.w = cvt_pk_bf16(x2[2], x2[3]);
                        *(u32x4*)((char*)HB + (size_t)(off0 + (unsigned)(ai * HALF + m * 16) * 128u)) = w;
                    }
            }
        } else if (wc == 0 || (wc == 1 && fq == 0)) {
#pragma unroll
            for (int n = 0; n < 2; ++n) {
                const int c0 = 32 * wc + 8 * fq + 4 * n;
#pragma unroll
                for (int ai = 0; ai < 2; ++ai)
#pragma unroll
                    for (int m = 0; m < 4; ++m) { const unsigned t = (unsigned)(row0 + ai * HALF + m * 16); *(f32x4*)((char*)SM + (size_t)((t * 64u + (unsigned)c0) * 4u)) = acc[ai][0][m][n]; }
            }
        }
    }
};
}

struct TJob { const float* src; bf16_t* dst; const float* rs; int K, N, ldw, map; };
__device__ __forceinline__ TJob get_job(const Params& p, int j) {
    unsigned char* ws = p.ws; TJob t; t.rs = nullptr; t.map = 0;
    switch (j) {
    case 0: t.src = p.in[6]; t.dst = (bf16_t*)(ws + WS_WIN); t.rs = p.in[3]; t.K = 1024; t.N = 3328; t.ldw = 3368; t.map = 1; break;
    case 1: t.src = p.in[6]; t.dst = (bf16_t*)(ws + WS_WVT); t.rs = p.in[3]; t.K = 1024; t.N = 256; t.ldw = 3368; t.map = 2; break;
    case 2: t.src = p.in[8]; t.dst = (bf16_t*)(ws + WS_WCMP1); t.K = 2048; t.N = 128; t.ldw = 128; break;
    case 3: t.src = p.in[11]; t.dst = (bf16_t*)(ws + WS_WCMP1) + 128 * 2048; t.K = 2048; t.N = 128; t.ldw = 128; break;
    case 4: t.src = p.in[17]; t.dst = (bf16_t*)(ws + WS_WOUT); t.K = 1024; t.N = 1024; t.ldw = 1024; break;
    case 5: t.src = p.in[18]; t.dst = (bf16_t*)(ws + WS_WSCIN); t.rs = p.in[3] + 1024; t.K = 1024; t.N = 3072; t.ldw = 3072; break;
    case 6: t.src = p.in[20]; t.dst = (bf16_t*)(ws + WS_WSCOUT); t.K = 1024; t.N = 1024; t.ldw = 1024; break;
    case 7: case 8: { const int l = j - 7; t.src = p.in[22] + (size_t)l * 1024 * 512; t.dst = (bf16_t*)(ws + WS_WQ) + (size_t)l * 512 * 1024; t.rs = p.in[4] + l * 1024; t.K = 1024; t.N = 512; t.ldw = 512; break; }
    case 9: case 10: { const int l = j - 9; t.src = p.in[23] + (size_t)l * 1024 * 1024; t.dst = (bf16_t*)(ws + WS_WKM) + (size_t)l * 512 * 1024; t.rs = p.in[21]; t.K = 1024; t.N = 512; t.ldw = 1024; break; }
    case 11: case 12: { const int l = j - 11; t.src = p.in[23] + (size_t)l * 1024 * 1024 + 512; t.dst = (bf16_t*)(ws + WS_WVM) + (size_t)l * 512 * 1024; t.rs = p.in[21]; t.K = 1024; t.N = 512; t.ldw = 1024; break; }
    case 13: case 14: { const int l = j - 13; t.src = p.in[24] + (size_t)l * 512 * 1024; t.dst = (bf16_t*)(ws + WS_WO) + (size_t)l * 1024 * 512; t.K = 512; t.N = 1024; t.ldw = 1024; break; }
    case 15: case 16: { const int l = j - 15; t.src = p.in[25] + (size_t)l * 1024 * 4096; t.dst = (bf16_t*)(ws + WS_W1) + (size_t)l * 4096 * 1024; t.rs = p.in[5] + l * 1024; t.K = 1024; t.N = 4096; t.ldw = 4096; break; }
    default: { const int l = j - 17; t.src = p.in[26] + (size_t)l * 4096 * 1024; t.dst = (bf16_t*)(ws + WS_W2) + (size_t)l * 1024 * 4096; t.K = 4096; t.N = 1024; t.ldw = 1024; break; }
    }
    return t;
}
constexpr int NJOBS = 19;
__device__ __forceinline__ int src_col(int map, int n) {
    if (map == 0) return n;
    if (map == 2) { const int vh = n >> 6, d = n & 63; return vh < 2 ? 896 + 64 * vh + d : 1152 + 64 * (vh - 2) + d; }
    if (n < 3072) { const int Hd = n >> 6, P = n & 63; const int d = P;
        int base;
        if (Hd < 8) base = 64 * Hd; else if (Hd < 10) base = 512 + 64 * (Hd - 8); else if (Hd < 12) base = 640 + 64 * (Hd - 10);
        else if (Hd < 14) base = 768 + 64 * (Hd - 12); else if (Hd < 16) base = 1024 + 64 * (Hd - 14); else if (Hd < 24) base = 1304 + 64 * (Hd - 16);
        else if (Hd < 32) base = 1816 + 64 * (Hd - 24); else if (Hd < 40) base = 2328 + 64 * (Hd - 32); else base = 2856 + 64 * (Hd - 40);
        return base + d; }
    const int c = n - 3072;
    if (c < 24) return 1280 + c; if (c < 32) return 2840 + (c - 24); if (c < 40) return 2848 + (c - 32);
    return -1;
}
__device__ __forceinline__ void rms_rows_bf16(const float* __restrict__ X, bf16_t* __restrict__ O, int rows, int gw, int nw, int lane) {
    for (int r = gw; r < rows; r += 2 * nw) {
        const int r2 = r + nw < rows ? r + nw : r;
        const float* xa = X + (size_t)r * 1024; const float* xb = X + (size_t)r2 * 1024; f32x4 va[4], vb[4]; float sa = 0.f, sb = 0.f;
#pragma unroll
        for (int i = 0; i < 4; ++i) { va[i] = *(const f32x4*)(xa + i * 256 + lane * 4); vb[i] = *(const f32x4*)(xb + i * 256 + lane * 4); }
#pragma unroll
        for (int i = 0; i < 4; ++i) { sa += va[i][0] * va[i][0] + va[i][1] * va[i][1] + va[i][2] * va[i][2] + va[i][3] * va[i][3]; sb += vb[i][0] * vb[i][0] + vb[i][1] * vb[i][1] + vb[i][2] * vb[i][2] + vb[i][3] * vb[i][3]; }
#pragma unroll
        for (int o = 32; o >= 1; o >>= 1) { sa += __shfl_xor(sa, o); sb += __shfl_xor(sb, o); }
        const float ra = rsqrtf(sa * (1.f / 1024.f) + 1e-6f), rb = rsqrtf(sb * (1.f / 1024.f) + 1e-6f);
#pragma unroll
        for (int i = 0; i < 4; ++i) { u32x2 w; w.x = cvt_pk_bf16(va[i][0] * ra, va[i][1] * ra); w.y = cvt_pk_bf16(va[i][2] * ra, va[i][3] * ra); *(u32x2*)(O + (size_t)r * 1024 + i * 256 + lane * 4) = w;
            w.x = cvt_pk_bf16(vb[i][0] * rb, vb[i][1] * rb); w.y = cvt_pk_bf16(vb[i][2] * rb, vb[i][3] * rb); *(u32x2*)(O + (size_t)r2 * 1024 + i * 256 + lane * 4) = w; }
    }
}
__device__ void phase_prep(const Params& p, unsigned char* lds) {
    const int tid = opaque_tid(), lane = tid & 63, wid = __builtin_amdgcn_readfirstlane(tid >> 6), G = gridDim.x, bid = blockIdx.x;
    const int gw = bid * 8 + wid, nw = G * 8;
    unsigned char* ws = p.ws;
    if (bid == 0 && tid < 64) ((unsigned*)(ws + WS_CTL))[tid] = 0u;
    {
        int tbase = 0;
        for (int j = 0; j < NJOBS; ++j) {
            const TJob jb = get_job(p, j);
            const int nnt = jb.N / 64, ntl = (jb.K / 64) * nnt;
            for (int lt = ((gw - tbase % nw) + nw) % nw; lt < ntl; lt += nw) {
                const int k0 = (lt / nnt) * 64, n0 = (lt % nnt) * 64;
                const int sc = src_col(jb.map, n0 + lane);
                const float* src = jb.src + (size_t)k0 * jb.ldw + (sc >= 0 ? sc : 0);
                float v[64];
#pragma unroll
                for (int k = 0; k < 64; ++k) v[k] = src[(size_t)k * jb.ldw];
                if (jb.rs) {
#pragma unroll
                    for (int k = 0; k < 64; ++k) v[k] *= jb.rs[k0 + k]; }
                if (sc < 0) {
#pragma unroll
                    for (int k = 0; k < 64; ++k) v[k] = 0.f; }
                bf16_t* dst = jb.dst + (size_t)(n0 + lane) * jb.K + k0;
#pragma unroll
                for (int k8 = 0; k8 < 8; ++k8) { u32x4 w; w.x = cvt_pk_bf16(v[8 * k8], v[8 * k8 + 1]); w.y = cvt_pk_bf16(v[8 * k8 + 2], v[8 * k8 + 3]); w.z = cvt_pk_bf16(v[8 * k8 + 4], v[8 * k8 + 5]); w.w = cvt_pk_bf16(v[8 * k8 + 6], v[8 * k8 + 7]); *(u32x4*)(dst + 8 * k8) = w; }
            }
            tbase += ntl;
        }
    }
    if (gw < 256) { const int c = gw, isv = c >> 7; const float* w1 = isv ? p.in[11] : p.in[8]; const float* pos = isv ? p.in[10] : p.in[7]; float s = 0.f;
        for (int k = lane; k < 2048; k += 64) s += pos[k] * w1[(size_t)k * 128 + (c & 127)];
        s = wave_sum(s); if (lane == 0) ((float*)(ws + WS_BIAS1))[c] = s; }
    { float* COS = (float*)(ws + WS_COS); float* SIN = (float*)(ws + WS_SIN); const int* pos = (const int*)p.in[2];
      for (int e = bid * 512 + tid; e < T_ * 32; e += G * 512) { const int t = e >> 5, i = e & 31; const float invf = powf(10000.f, -(float)(2 * i) / 64.f); const float ang = (float)pos[t] * invf; float sn, cs; sincosf(ang, &sn, &cs); COS[e] = cs; SIN[e] = sn; } }
    rms_rows_bf16(p.in[1], (bf16_t*)(ws + WS_MEMN), 4096, gw, nw, lane);
    rms_rows_bf16(p.in[0], (bf16_t*)(ws + WS_ACT), T_, gw, nw, lane);
}

template <int D, int KST>
__device__ __forceinline__ void qk_tile(const LAS bf16_t* Kt, const bf16x8 (&qf)[D / 32], f32x4 (&st)[4], int lane) {
    const int r = lane & 15, q4 = lane >> 4;
#pragma unroll
    for (int ti = 0; ti < 4; ++ti) {
        const int key = 32 * (ti >> 1) + (r >> 2) * 8 + 4 * (ti & 1) + (r & 3);
        f32x4 a = (f32x4){0.f, 0.f, 0.f, 0.f};
#pragma unroll
        for (int kc = 0; kc < D / 32; ++kc) { const bf16x8 kA = *(const LAS bf16x8*)(Kt + key * KST + 32 * (key >> 4) + 32 * kc + 8 * q4); a = MFMA16(kA, qf[kc], a); }
        st[ti] = a;
    }
}
template <int D, int VST>
__device__ __forceinline__ void pv_tile(const LAS bf16_t* Vt, const f32x4 (&pp)[4], f32x4 (&o)[D / 16], int lane) {
    const int r = lane & 15, q4 = lane >> 4;
#pragma unroll
    for (int c2 = 0; c2 < 2; ++c2) {
        u32x4 pk; pk.x = cvt_pk_bf16(pp[2 * c2][0], pp[2 * c2][1]); pk.y = cvt_pk_bf16(pp[2 * c2][2], pp[2 * c2][3]); pk.z = cvt_pk_bf16(pp[2 * c2 + 1][0], pp[2 * c2 + 1][1]); pk.w = cvt_pk_bf16(pp[2 * c2 + 1][2], pp[2 * c2 + 1][3]);
        const bf16x8 pB = __builtin_bit_cast(bf16x8, pk);
#pragma unroll
        for (int dt = 0; dt < D / 16; ++dt) { const bf16x8 vA = *(const LAS bf16x8*)(Vt + (16 * dt + r) * VST + 32 * c2 + 8 * q4); o[dt] = MFMA16(vA, pB, o[dt]); }
    }
}
template <int D, int VST>
__device__ __forceinline__ void softmax_pv(f32x4 (&st)[4], unsigned vm, float& mrun, float& lrun, f32x4 (&o)[D / 16], const LAS bf16_t* Vt, int lane) {
    float mx = -1e30f;
#pragma unroll
    for (int ti = 0; ti < 4; ++ti)
#pragma unroll
        for (int jj = 0; jj < 4; ++jj) if ((vm >> (ti * 4 + jj)) & 1u) mx = fmaxf(mx, st[ti][jj]);
    mx = fmaxf(mx, __shfl_xor(mx, 16)); mx = fmaxf(mx, __shfl_xor(mx, 32));
    const float mn = fmaxf(mrun, mx); const float alpha = __builtin_amdgcn_exp2f(mrun - mn); mrun = mn;
    float rs = 0.f;
#pragma unroll
    for (int ti = 0; ti < 4; ++ti)
#pragma unroll
        for (int jj = 0; jj < 4; ++jj) { const float pv = ((vm >> (ti * 4 + jj)) & 1u) ? __builtin_amdgcn_exp2f(st[ti][jj] - mn) : 0.f; st[ti][jj] = pv; rs += pv; }
    lrun = lrun * alpha + rs;
#pragma unroll
    for (int dt = 0; dt < D / 16; ++dt) o[dt] *= alpha;
    pv_tile<D, VST>(Vt, st, o, lane);
}

template <int D, int KST>
__device__ __forceinline__ void qk_tile_bias(const LAS bf16_t* Kt, const bf16x8 (&qf)[D / 32], f32x4 (&st)[4], float bias, int lane) {
    const int r = lane & 15, q4 = lane >> 4;
#pragma unroll
    for (int ti = 0; ti < 4; ++ti) {
        const int key = 32 * (ti >> 1) + (r >> 2) * 8 + 4 * (ti & 1) + (r & 3);
        f32x4 a = (f32x4){bias, bias, bias, bias};
#pragma unroll
        for (int kc = 0; kc < D / 32; ++kc) { const bf16x8 kA = *(const LAS bf16x8*)(Kt + key * KST + 32 * (key >> 4) + 32 * kc + 8 * q4); a = MFMA16(kA, qf[kc], a); }
        st[ti] = a;
    }
}
template <int D, int VST>
__device__ __forceinline__ void softmax_pv_fast(f32x4 (&st)[4], float& mrun, float& lrun, f32x4 (&o)[D / 16], const LAS bf16_t* Vt, int lane) {
    float mx = fmaxf(fmaxf(fmaxf(st[0][0], st[0][1]), fmaxf(st[0][2], st[0][3])), fmaxf(fmaxf(st[1][0], st[1][1]), fmaxf(st[1][2], st[1][3])));
    mx = fmaxf(mx, fmaxf(fmaxf(fmaxf(st[2][0], st[2][1]), fmaxf(st[2][2], st[2][3])), fmaxf(fmaxf(st[3][0], st[3][1]), fmaxf(st[3][2], st[3][3]))));
    mx = fmaxf(mx, __shfl_xor(mx, 16)); mx = fmaxf(mx, __shfl_xor(mx, 32));
    const float mn = fmaxf(mrun, mx); const float alpha = __builtin_amdgcn_exp2f(mrun - mn); const bool grow = mn > mrun; mrun = mn;
    f32x4 rs4 = (f32x4){0.f, 0.f, 0.f, 0.f};
#pragma unroll
    for (int ti = 0; ti < 4; ++ti) { const f32x4 d = st[ti] - mn; f32x4 e; e[0] = __builtin_amdgcn_exp2f(d[0]); e[1] = __builtin_amdgcn_exp2f(d[1]); e[2] = __builtin_amdgcn_exp2f(d[2]); e[3] = __builtin_amdgcn_exp2f(d[3]); st[ti] = e; rs4 += e; }
    lrun = lrun * alpha + (rs4[0] + rs4[1]) + (rs4[2] + rs4[3]);
    if (__any(grow)) {
#pragma unroll
        for (int dt = 0; dt < D / 16; ++dt) o[dt] *= alpha; }
    pv_tile<D, VST>(Vt, st, o, lane);
}

constexpr int NSA_KC = 0, NSA_VC = 38912, NSA_PS = 72704, NSA_IMP = 105472, NSA_MASK = 113664;
constexpr int KT72 = 64 * 72 + 128, KT136 = 64 * 136 + 128;
__device__ void nsa_item(const Params& p, unsigned char* ldsg, int item) {
    LAS unsigned char* lds = (LAS unsigned char*)ldsg;
    const int tid = opaque_tid(), lane = tid & 63, wid = __builtin_amdgcn_readfirstlane(tid >> 6), c = lane & 15, q4 = lane >> 4, tl = c >> 2, hh = c & 3;
    const int bg = item & 31, qt = 127 - (item >> 5), g = bg >> 4, b = bg & 15, t0 = qt * 32;
    const int t = t0 + 4 * wid + tl, h = 4 * g + hh, tok = b * SQ + t;
    unsigned char* ws = p.ws;
    const bf16_t* HB = (const bf16_t*)(ws + WS_HB); const float* SM = (const float*)(ws + WS_SM);
    bf16x8 qf[2];
    { const bf16_t* qrow = HB + ((size_t)(h * 16 + b) * SQ + t) * 64; qf[0] = *(const bf16x8*)(qrow + 8 * q4); qf[1] = *(const bf16x8*)(qrow + 32 + 8 * q4); }
    const float gate0 = sigmoidf_(SM[(size_t)tok * 64 + h * 3 + 0]), gate1 = sigmoidf_(SM[(size_t)tok * 64 + h * 3 + 1]), gate2 = sigmoidf_(SM[(size_t)tok * 64 + h * 3 + 2]);
    f32x4 outacc[4];
#pragma unroll
    for (int dt = 0; dt < 4; ++dt) outacc[dt] = (f32x4){0.f, 0.f, 0.f, 0.f};
    LAS bf16_t* Kc = (LAS bf16_t*)(lds + NSA_KC); LAS bf16_t* Vc = (LAS bf16_t*)(lds + NSA_VC);
    LAS float* PS = (LAS float*)(lds + NSA_PS); LAS float* IMP = (LAS float*)(lds + NSA_IMP); LAS u64* MASK = (LAS u64*)(lds + NSA_MASK);
    {
        int nvmax = t0 / 16 + 1; if (nvmax > 255) nvmax = 255;
        const int ntc = (nvmax + 63) >> 6;
        const bf16_t* KCg = (const bf16_t*)(ws + WS_KC) + (size_t)bg * 256 * 64; const bf16_t* VCg = (const bf16_t*)(ws + WS_VCT) + (size_t)bg * 64 * 256;
        { const int lr_ = tid >> 3, lc_ = (tid & 7) * 8; u32x4 kr[4], vr[4];
#pragma unroll
          for (int kt = 0; kt < 4; ++kt) if (kt < ntc) { kr[kt] = *(const u32x4*)(KCg + (size_t)(64 * kt + lr_) * 64 + lc_); vr[kt] = *(const u32x4*)(VCg + (size_t)lr_ * 256 + 64 * kt + lc_); }
#pragma unroll
          for (int kt = 0; kt < 4; ++kt) if (kt < ntc) { *(LAS u32x4*)(Kc + kt * KT72 + lr_ * 72 + 32 * (lr_ >> 4) + lc_) = kr[kt]; *(LAS u32x4*)(Vc + lr_ * 264 + 64 * kt + lc_) = vr[kt]; } }
        __syncthreads();
        const int nv = (t >= 31) ? (t - 31) / 16 + 1 : 0;
        f32x4 sc[4][4];
#pragma unroll
        for (int kt = 0; kt < 4; ++kt) {
            if (kt < ntc) qk_tile<64, 72>(Kc + kt * KT72, qf, sc[kt], lane);
            else {
#pragma unroll
                for (int ti = 0; ti < 4; ++ti) sc[kt][ti] = (f32x4){0.f, 0.f, 0.f, 0.f}; }
        }
        float mx = -1e30f;
#pragma unroll
        for (int kt = 0; kt < 4; ++kt)
#pragma unroll
            for (int ti = 0; ti < 4; ++ti)
#pragma unroll
                for (int jj = 0; jj < 4; ++jj) { const int n = 64 * kt + 32 * (ti >> 1) + 8 * q4 + 4 * (ti & 1) + jj; if (n < nv) mx = fmaxf(mx, sc[kt][ti][jj]); }
        mx = fmaxf(mx, __shfl_xor(mx, 16)); mx = fmaxf(mx, __shfl_xor(mx, 32));
        float ls = 0.f;
#pragma unroll
        for (int kt = 0; kt < 4; ++kt)
#pragma unroll
            for (int ti = 0; ti < 4; ++ti)
#pragma unroll
                for (int jj = 0; jj < 4; ++jj) { const int n = 64 * kt + 32 * (ti >> 1) + 8 * q4 + 4 * (ti & 1) + jj; const float pv = (n < nv) ? __builtin_amdgcn_exp2f(sc[kt][ti][jj] - mx) : 0.f; sc[kt][ti][jj] = pv; ls += pv; }
        ls += __shfl_xor(ls, 16); ls += __shfl_xor(ls, 32);
        const float inv = ls > 0.f ? 1.f / ls : 0.f;
#pragma unroll
        for (int kt = 0; kt < 4; ++kt)
#pragma unroll
            for (int ti = 0; ti < 4; ++ti)
#pragma unroll
                for (int jj = 0; jj < 4; ++jj) { const float pn = sc[kt][ti][jj] * inv; sc[kt][ti][jj] = pn; float v = pn; v += __shfl_xor(v, 1); v += __shfl_xor(v, 2);
                    if (hh == 0) PS[(4 * wid + tl) * 256 + 64 * kt + 32 * (ti >> 1) + 8 * q4 + 4 * (ti & 1) + jj] = v; }
        f32x4 o[4];
#pragma unroll
        for (int dt = 0; dt < 4; ++dt) o[dt] = (f32x4){0.f, 0.f, 0.f, 0.f};
#pragma unroll
        for (int kt = 0; kt < 4; ++kt) if (kt < ntc) pv_tile<64, 264>(Vc + 64 * kt, sc[kt], o, lane);
#pragma unroll
        for (int dt = 0; dt < 4; ++dt) outacc[dt] += o[dt] * gate0;
    }
    __syncthreads();
    const u32x4 kv_first = *(const u32x4*)(HB + (size_t)(12 + g) * 16 * SQ * 64 + (size_t)b * SQ * 64 + (size_t)(tid >> 3) * 64 + (tid & 7) * 8);
    const u32x4 vv_first = *(const u32x4*)((const bf16_t*)(ws + WS_VT) + (size_t)g * 64 * T_ + (size_t)b * SQ + (size_t)(tid >> 3) * T_ + (tid & 7) * 8);
    {
        const int tk = tid >> 4, tq = t0 + tk, cur = tq >> 6;
#pragma unroll
        for (int e = 0; e < 4; ++e) { const int jb = (tid & 15) + 16 * e; const LAS float* pr = PS + tk * 256 + 4 * jb;
            float v = pr[0] + pr[1] + pr[2] + 0.5f * pr[3] + (jb > 0 ? 0.5f * pr[-1] : 0.f);
            const bool forced = (jb == 0) || (jb == cur) || (jb == cur - 1);
            v = (jb <= cur) ? (forced ? v + 1000.f : v) : -1.f;
            IMP[tk * 64 + jb] = v; }
    }
    __syncthreads();
    {
        const float v0 = IMP[(4 * wid + 0) * 64 + lane], v1 = IMP[(4 * wid + 1) * 64 + lane], v2 = IMP[(4 * wid + 2) * 64 + lane], v3 = IMP[(4 * wid + 3) * 64 + lane];
        int r0 = 0, r1 = 0, r2 = 0, r3 = 0;
#pragma unroll
        for (int j = 0; j < 64; ++j) { const float s0 = RDLANE(v0, j), s1 = RDLANE(v1, j), s2 = RDLANE(v2, j), s3 = RDLANE(v3, j); const bool lo = j < lane;
            r0 += (s0 > v0 || (s0 == v0 && lo)) ? 1 : 0; r1 += (s1 > v1 || (s1 == v1 && lo)) ? 1 : 0; r2 += (s2 > v2 || (s2 == v2 && lo)) ? 1 : 0; r3 += (s3 > v3 || (s3 == v3 && lo)) ? 1 : 0; }
        const u64 m0 = __ballot(r0 < 16), m1 = __ballot(r1 < 16), m2 = __ballot(r2 < 16), m3 = __ballot(r3 < 16);
        if (lane == 0) { MASK[4 * wid + 0] = m0; MASK[4 * wid + 1] = m1; MASK[4 * wid + 2] = m2; MASK[4 * wid + 3] = m3; }
    }
    __syncthreads();
    const u64 mymask = MASK[4 * wid + tl];
    u64 uni = MASK[lane & 31];
#pragma unroll
    for (int o = 16; o >= 1; o >>= 1) uni |= __shfl_xor(uni, o);
    const int cur = t0 >> 6;
    uni &= (cur == 63) ? ~0ull : ((2ull << cur) - 1ull);
    uni = ((u64)(unsigned)__builtin_amdgcn_readfirstlane((unsigned)(uni >> 32)) << 32) | (u64)(unsigned)__builtin_amdgcn_readfirstlane((unsigned)uni);
    const bf16_t* VTg = (const bf16_t*)(ws + WS_VT);
#pragma unroll 1
    for (int br = 1; br <= 2; ++br) {
        const bf16_t* Kg = HB + (size_t)((br == 1 ? 12 : 14) + g) * 16 * SQ * 64 + (size_t)b * SQ * 64;
        const bf16_t* Vg = VTg + (size_t)((br == 1 ? 0 : 2) + g) * 64 * T_ + (size_t)b * SQ;
        u64 list;
        if (br == 1) list = uni;
        else { const int lo = (t0 >= 511 ? (t0 - 511) >> 6 : 0), hi = t0 >> 6; list = ((hi == 63) ? ~0ull : ((2ull << hi) - 1ull)) & ~((1ull << lo) - 1ull); }
        float mrun = -1e30f, lrun = 0.f; f32x4 o[4];
#pragma unroll
        for (int dt = 0; dt < 4; ++dt) o[dt] = (f32x4){0.f, 0.f, 0.f, 0.f};
        const int lr = tid >> 3, lch = tid & 7;
        int j = __builtin_ctzll(list); list &= list - 1;
        { u32x4 kv = kv_first, vv = vv_first;
          if (br != 1) { kv = *(const u32x4*)(Kg + (size_t)(64 * j + lr) * 64 + lch * 8); vv = *(const u32x4*)(Vg + (size_t)lr * T_ + 64 * j + lch * 8); }
          *(LAS u32x4*)(Kc + lr * 72 + 32 * (lr >> 4) + lch * 8) = kv; *(LAS u32x4*)(Vc + lr * 72 + lch * 8) = vv; }
        __syncthreads();
        int buf = 0;
        for (;;) {
            const int jn = list ? __builtin_ctzll(list) : -1; list &= list - 1;
            u32x4 kv, vv;
            if (jn >= 0) { kv = *(const u32x4*)(Kg + (size_t)(64 * jn + lr) * 64 + lch * 8); vv = *(const u32x4*)(Vg + (size_t)lr * T_ + 64 * jn + lch * 8); }
            unsigned vm = 0u;
            if (br == 1) { if ((mymask >> j) & 1ull) { if (j < cur) vm = 0xffffu; else {
#pragma unroll
                        for (int ti = 0; ti < 4; ++ti)
#pragma unroll
                            for (int jj = 0; jj < 4; ++jj) { const int key = 64 * j + 32 * (ti >> 1) + 8 * q4 + 4 * (ti & 1) + jj; if (key <= t) vm |= 1u << (ti * 4 + jj); } } } }
            else {
                const int tw0 = t0 + 4 * wid;
                if (64 * j + 63 <= tw0 && 64 * j > tw0 + 3 - 512) vm = 0xffffu;
                else {
#pragma unroll
                    for (int ti = 0; ti < 4; ++ti)
#pragma unroll
                        for (int jj = 0; jj < 4; ++jj) { const int key = 64 * j + 32 * (ti >> 1) + 8 * q4 + 4 * (ti & 1) + jj; if (key <= t && key > t - 512) vm |= 1u << (ti * 4 + jj); } } }
            if (__any(vm != 0u)) { f32x4 st[4];
                if (!__any(vm != 0u && vm != 0xffffu)) { qk_tile_bias<64, 72>(Kc + buf * KT72, qf, st, vm ? 0.f : -INFINITY, lane); softmax_pv_fast<64, 72>(st, mrun, lrun, o, Vc + buf * 4608, lane); }
                else { qk_tile<64, 72>(Kc + buf * KT72, qf, st, lane); softmax_pv<64, 72>(st, vm, mrun, lrun, o, Vc + buf * 4608, lane); } }
            if (jn >= 0) { *(LAS u32x4*)(Kc + (buf ^ 1) * KT72 + lr * 72 + 32 * (lr >> 4) + lch * 8) = kv; *(LAS u32x4*)(Vc + (buf ^ 1) * 4608 + lr * 72 + lch * 8) = vv; }
            __syncthreads();
            if (jn < 0) break;
            j = jn; buf ^= 1;
        }
        float lt = lrun; lt += __shfl_xor(lt, 16); lt += __shfl_xor(lt, 32);
        const float sc_ = (br == 1 ? gate1 : gate2) * (lt > 0.f ? 1.f / lt : 0.f);
#pragma unroll
        for (int dt = 0; dt < 4; ++dt) outacc[dt] += o[dt] * sc_;
    }
    { bf16_t* dst = (bf16_t*)(ws + WS_ACT) + (size_t)tok * 1024 + h * 64 + 4 * q4;
#pragma unroll
      for (int dt = 0; dt < 4; ++dt) { u32x2 w; w.x = cvt_pk_bf16(outacc[dt][0], outacc[dt][1]); w.y = cvt_pk_bf16(outacc[dt][2], outacc[dt][3]); *(u32x2*)(dst + 16 * dt) = w; } }
}

__device__ void xattn_block(const Params& p, unsigned char* ldsg, int blk, int layer) {
    LAS unsigned char* lds = (LAS unsigned char*)ldsg;
    const int tid = opaque_tid(), lane = tid & 63, wid = __builtin_amdgcn_readfirstlane(tid >> 6), c = lane & 15, q4 = lane >> 4;
    const int qq = blk & 3, h = (blk >> 2) & 3, b = blk >> 4;
    unsigned char* ws = p.ws;
    const bf16_t* QX = (const bf16_t*)(ws + WS_QX); const bf16_t* KM = (const bf16_t*)(ws + WS_KMEM) + (size_t)layer * 4096 * 512; const bf16_t* VM = (const bf16_t*)(ws + WS_VMT) + (size_t)layer * 512 * 4096;
    LAS bf16_t* Kb = (LAS bf16_t*)lds;
    LAS bf16_t* Vb = (LAS bf16_t*)(lds + 4 * KT136 * 2);
    __syncthreads();
#pragma unroll
    for (int i = 0; i < 8; ++i) { const int e = tid + 512 * i; const int row = e >> 4, rl = row & 63; *(LAS u32x4*)(Kb + (row >> 6) * KT136 + rl * 136 + 32 * (rl >> 4) + (e & 15) * 8) = *(const u32x4*)(KM + (size_t)(b * 256 + row) * 512 + h * 128 + (e & 15) * 8); }
#pragma unroll
    for (int i = 0; i < 8; ++i) { const int e = tid + 512 * i; *(LAS u32x4*)(Vb + (e >> 5) * 264 + (e & 31) * 8) = *(const u32x4*)(VM + (size_t)(h * 128 + (e >> 5)) * 4096 + b * 256 + (e & 31) * 8); }
    __syncthreads();
    bf16x8 qn[4];
#pragma unroll
    for (int kc = 0; kc < 4; ++kc) qn[kc] = *(const bf16x8*)(QX + (size_t)(b * SQ + (qq * 8) * 128 + wid * 16 + c) * 512 + h * 128 + 32 * kc + 8 * q4);
#pragma unroll 1
    for (int qt = 0; qt < 8; ++qt) {
        const int tok = b * SQ + (qq * 8 + qt) * 128 + wid * 16 + c;
        bf16x8 qf[4];
#pragma unroll
        for (int kc = 0; kc < 4; ++kc) qf[kc] = qn[kc];
        if (qt < 7) {
#pragma unroll
            for (int kc = 0; kc < 4; ++kc) qn[kc] = *(const bf16x8*)(QX + (size_t)(tok + 128) * 512 + h * 128 + 32 * kc + 8 * q4); }
        float mrun = -1e30f, lrun = 0.f; f32x4 o[8];
#pragma unroll
        for (int dt = 0; dt < 8; ++dt) o[dt] = (f32x4){0.f, 0.f, 0.f, 0.f};
#pragma unroll 1
        for (int j = 0; j < 4; ++j) { f32x4 st[4]; qk_tile<128, 136>(Kb + j * KT136, qf, st, lane); softmax_pv_fast<128, 264>(st, mrun, lrun, o, Vb + 64 * j, lane); }
        float lt = lrun; lt += __shfl_xor(lt, 16); lt += __shfl_xor(lt, 32);
        const float inv = 1.f / lt;
        bf16_t* dst = (bf16_t*)(ws + WS_OX) + (size_t)tok * 512 + h * 128 + 4 * q4;
#pragma unroll
        for (int dt = 0; dt < 8; ++dt) { u32x2 w; w.x = cvt_pk_bf16(o[dt][0] * inv, o[dt][1] * inv); w.y = cvt_pk_bf16(o[dt][2] * inv, o[dt][3] * inv); *(u32x2*)(dst + 16 * dt) = w; }
    }
}

__device__ void gdn_g1(const Params& p, int gw, int nw, int lane) {
    unsigned char* ws = p.ws;
    const bf16_t* __restrict__ HB = (const bf16_t*)(ws + WS_HB); const float* __restrict__ SM = (const float*)(ws + WS_SM); const float* __restrict__ cw = p.in[13];
    bf16_t* __restrict__ QN = (bf16_t*)(ws + WS_QN); bf16_t* __restrict__ KN = (bf16_t*)(ws + WS_KN); bf16_t* __restrict__ VB = (bf16_t*)(ws + WS_VB);
    const int tl = lane >> 4, dq = (lane & 15) * 4;
    for (int cid = gw; cid < 8192; cid += nw) {
        const int bh = cid >> 6, cc = cid & 63, h = bh >> 4, b = bh & 15, s0 = cc * 64;
        const bf16_t* xs[3] = { HB + ((size_t)((16 + h) * 16 + b) * SQ) * 64 + dq, HB + ((size_t)((24 + h) * 16 + b) * SQ) * 64 + dq, HB + ((size_t)((32 + h) * 16 + b) * SQ) * 64 + dq };
        f32x4 wt[3][4];
#pragma unroll
        for (int x = 0; x < 3; ++x)
#pragma unroll
            for (int j = 0; j < 4; ++j) wt[x][j] = *(const f32x4*)(cw + j * 1536 + x * 512 + h * 64 + dq);
#pragma unroll 4
        for (int it = 0; it < 16; ++it) {
            const int s = s0 + 4 * it + tl;
            f32x4 y[3];
#pragma unroll
            for (int x = 0; x < 3; ++x) {
                f32x4 acc = (f32x4){0.f, 0.f, 0.f, 0.f};
#pragma unroll
                for (int j = 0; j < 4; ++j) { const int sj = s - 3 + j; u32x2 raw = (u32x2){0u, 0u}; if (sj >= 0) raw = *(const u32x2*)(xs[x] + (size_t)sj * 64);
                    const f32x4 xv = (f32x4){bf2f((bf16_t)(raw.x & 0xffff)), bf2f((bf16_t)(raw.x >> 16)), bf2f((bf16_t)(raw.y & 0xffff)), bf2f((bf16_t)(raw.y >> 16))};
                    acc += wt[x][j] * xv; }
#pragma unroll
                for (int e = 0; e < 4; ++e) acc[e] = siluf_(acc[e]);
                y[x] = acc;
            }
            float sq = y[0][0] * y[0][0] + y[0][1] * y[0][1] + y[0][2] * y[0][2] + y[0][3] * y[0][3], sk = y[1][0] * y[1][0] + y[1][1] * y[1][1] + y[1][2] * y[1][2] + y[1][3] * y[1][3];
#pragma unroll
            for (int o = 1; o < 16; o <<= 1) { sq += __shfl_xor(sq, o); sk += __shfl_xor(sk, o); }
            const float rq = rsqrtf(sq + 1e-6f) * 0.125f, rk = rsqrtf(sk + 1e-6f);
            const float beta = sigmoidf_(SM[(size_t)(b * SQ + s) * 64 + 32 + h]);
            const size_t o = (size_t)cid * 4096 + (4 * it + tl) * 64 + dq;
            u32x2 w; w.x = cvt_pk_bf16(y[0][0] * rq, y[0][1] * rq); w.y = cvt_pk_bf16(y[0][2] * rq, y[0][3] * rq); *(u32x2*)(QN + o) = w;
            w.x = cvt_pk_bf16(y[1][0] * rk, y[1][1] * rk); w.y = cvt_pk_bf16(y[1][2] * rk, y[1][3] * rk); *(u32x2*)(KN + o) = w;
            w.x = cvt_pk_bf16(y[2][0] * beta, y[2][1] * beta); w.y = cvt_pk_bf16(y[2][2] * beta, y[2][3] * beta); *(u32x2*)(VB + o) = w;
        }
    }
}
__device__ void gdn_g2(const Params& p, LAS float* Aw, int cid, int lane) {
    unsigned char* ws = p.ws;
    const float* SM = (const float*)(ws + WS_SM);
    bf16_t* QN = (bf16_t*)(ws + WS_QN) + (size_t)cid * 4096; bf16_t* KN = (bf16_t*)(ws + WS_KN) + (size_t)cid * 4096; bf16_t* VB = (bf16_t*)(ws + WS_VB) + (size_t)cid * 4096;
    bf16_t* QKM = (bf16_t*)(ws + WS_QKM) + (size_t)cid * 4096; bf16_t* KDT = (bf16_t*)(ws + WS_KDT) + (size_t)cid * 4096;
    const int r = lane & 15, q4 = lane >> 4;
    const int bh = cid >> 6, cc = cid & 63, h = bh >> 4, b = bh & 15, tok0 = b * SQ + cc * 64;
    float gcs; { const float xx = SM[(size_t)(tok0 + lane) * 64 + 24 + h] + p.in[15][h]; const float sp = xx > 20.f ? xx : log1pf(__expf(xx)); gcs = -__expf(p.in[14][h]) * sp; }
    const float beta = sigmoidf_(SM[(size_t)(tok0 + lane) * 64 + 32 + h]);
#pragma unroll
    for (int o = 1; o < 64; o <<= 1) { const float v = __shfl_up(gcs, o); if (lane >= o) gcs += v; }
    const float gl = __shfl(gcs, 63);
    if (lane == 0) ((float*)(ws + WS_EGL))[cid] = __expf(gl);
    const float wcoef = beta * __expf(gcs), kdcoef = __expf(gl - gcs), qcoef = __expf(gcs);
    {
        bf16x8 kcol[4][2];
#pragma unroll
        for (int ct = 0; ct < 4; ++ct)
#pragma unroll
            for (int kc = 0; kc < 2; ++kc) kcol[ct][kc] = *(const bf16x8*)(KN + (16 * ct + r) * 64 + 32 * kc + 8 * q4);
        float gj[4];
#pragma unroll
        for (int ct = 0; ct < 4; ++ct) gj[ct] = __shfl(gcs, 16 * ct + r);
#pragma unroll 1
        for (int rt = 0; rt < 4; ++rt) {
            bf16x8 krow[2], qrow[2];
#pragma unroll
            for (int kc = 0; kc < 2; ++kc) { krow[kc] = *(const bf16x8*)(KN + (16 * rt + r) * 64 + 32 * kc + 8 * q4); qrow[kc] = *(const bf16x8*)(QN + (16 * rt + r) * 64 + 32 * kc + 8 * q4); }
            float gi[4], bi[4];
#pragma unroll
            for (int jj = 0; jj < 4; ++jj) { gi[jj] = __shfl(gcs, 16 * rt + 4 * q4 + jj); bi[jj] = __shfl(beta, 16 * rt + 4 * q4 + jj); }
#pragma unroll
            for (int ct = 0; ct < 4; ++ct) {
                f32x4 a = (f32x4){0.f, 0.f, 0.f, 0.f}, qa = (f32x4){0.f, 0.f, 0.f, 0.f};
                if (ct <= rt) { a = MFMA16(krow[0], kcol[ct][0], a); a = MFMA16(krow[1], kcol[ct][1], a); qa = MFMA16(qrow[0], kcol[ct][0], qa); qa = MFMA16(qrow[1], kcol[ct][1], qa); }
#pragma unroll
                for (int jj = 0; jj < 4; ++jj) { const int i = 16 * rt + 4 * q4 + jj, j = 16 * ct + r;
                    const float dec = (j <= i) ? __expf(gi[jj] - gj[ct]) : 0.f;
                    Aw[i * 64 + j] = (j < i) ? a[jj] * bi[jj] * dec : 0.f;
                    QKM[i * 64 + j] = f2bf(qa[jj] * dec); }
            }
        }
    }
    asm volatile("s_waitcnt lgkmcnt(0)" ::: "memory");
    __builtin_amdgcn_wave_barrier();
    float arow[64];
#pragma unroll
    for (int j4 = 0; j4 < 16; ++j4) { const f32x4 a4 = *(const LAS f32x4*)(Aw + lane * 64 + 4 * j4); arow[4 * j4] = a4[0]; arow[4 * j4 + 1] = a4[1]; arow[4 * j4 + 2] = a4[2]; arow[4 * j4 + 3] = a4[3]; }
    asm volatile("s_waitcnt lgkmcnt(0)" ::: "memory");
    __builtin_amdgcn_wave_barrier();
    typedef float f32x2_ __attribute__((ext_vector_type(2)));
    const int crow = lane >> 3, ccol = (lane & 7) * 8;
#define G2_LOADPUT(SRC) do { u32x4 tch[8]; _Pragma("unroll") for (int k = 0; k < 8; ++k) tch[k] = *(const u32x4*)((SRC) + (crow + 8 * k) * 64 + ccol); \
        _Pragma("unroll") for (int k = 0; k < 8; ++k) { const unsigned w_[4] = {tch[k].x, tch[k].y, tch[k].z, tch[k].w}; \
            _Pragma("unroll") for (int e = 0; e < 8; ++e) Aw[(crow + 8 * k) * 65 + ccol + e] = (e & 1) ? __uint_as_float(w_[e >> 1] & 0xffff0000u) : __uint_as_float(w_[e >> 1] << 16); \
            asm volatile("" ::: "memory"); } } while (0)
#define G2_SOLVE(rowc) do { _Pragma("unroll 1") for (int c0 = 0; c0 < 64; c0 += 4) { \
            f32x2_ xa = (f32x2_){Aw[lane * 65 + c0] * (rowc), Aw[lane * 65 + c0 + 1] * (rowc)}, xb = (f32x2_){Aw[lane * 65 + c0 + 2] * (rowc), Aw[lane * 65 + c0 + 3] * (rowc)}; \
            _Pragma("unroll") for (int j = 0; j < 63; ++j) { const f32x2_ sa = (f32x2_){RDLANE(xa.x, j), RDLANE(xa.y, j)}, sb = (f32x2_){RDLANE(xb.x, j), RDLANE(xb.y, j)}; \
                const f32x2_ aj = (f32x2_){arow[j], arow[j]}; xa = __builtin_elementwise_fma(-aj, sa, xa); xb = __builtin_elementwise_fma(-aj, sb, xb); } \
            Aw[lane * 65 + c0] = xa.x; Aw[lane * 65 + c0 + 1] = xa.y; Aw[lane * 65 + c0 + 2] = xb.x; Aw[lane * 65 + c0 + 3] = xb.y; } } while (0)
#define G2_GET(DST) do { _Pragma("unroll") for (int k = 0; k < 8; ++k) { const LAS float* t_ = Aw + (crow + 8 * k) * 65 + ccol; u32x4 w_; \
            w_.x = cvt_pk_bf16(t_[0], t_[1]); w_.y = cvt_pk_bf16(t_[2], t_[3]); w_.z = cvt_pk_bf16(t_[4], t_[5]); w_.w = cvt_pk_bf16(t_[6], t_[7]); *(u32x4*)((DST) + (crow + 8 * k) * 64 + ccol) = w_; \
            if (k & 1) asm volatile("" ::: "memory"); } } while (0)
#define G2_SYNC() do { asm volatile("s_waitcnt lgkmcnt(0)" ::: "memory"); __builtin_amdgcn_wave_barrier(); } while (0)
#pragma unroll 1
    for (int pass = 0; pass < 2; ++pass) {
        bf16_t* RX = pass == 0 ? VB : KN;
        G2_LOADPUT(RX);
        G2_SYNC();
        if (pass == 1) {
#pragma unroll 2
            for (int i8 = 0; i8 < 8; ++i8) { unsigned kd[4];
#pragma unroll
                for (int e = 0; e < 8; ++e) { const int i = 8 * i8 + e; const unsigned v = (unsigned)f2bf(Aw[i * 65 + lane] * RDLANE(kdcoef, i));
                    if (e & 1) kd[e >> 1] |= v << 16; else kd[e >> 1] = v; }
                u32x4 w; w.x = kd[0]; w.y = kd[1]; w.z = kd[2]; w.w = kd[3]; *(u32x4*)(KDT + lane * 64 + 8 * i8) = w; }
            G2_SYNC();
        }
        const float rowc = pass == 0 ? 1.f : wcoef;
        G2_SOLVE(rowc);
        G2_SYNC();
        G2_GET(RX);
        G2_SYNC();
    }
    { u32x4 tch[8];
#pragma unroll
      for (int k = 0; k < 8; ++k) tch[k] = *(const u32x4*)(QN + (crow + 8 * k) * 64 + ccol);
#pragma unroll
      for (int k = 0; k < 8; ++k) { const float qc = __shfl(qcoef, crow + 8 * k); const unsigned w_[4] = {tch[k].x, tch[k].y, tch[k].z, tch[k].w}; u32x4 o_;
        o_.x = cvt_pk_bf16(__uint_as_float(w_[0] << 16) * qc, __uint_as_float(w_[0] & 0xffff0000u) * qc); o_.y = cvt_pk_bf16(__uint_as_float(w_[1] << 16) * qc, __uint_as_float(w_[1] & 0xffff0000u) * qc);
        o_.z = cvt_pk_bf16(__uint_as_float(w_[2] << 16) * qc, __uint_as_float(w_[2] & 0xffff0000u) * qc); o_.w = cvt_pk_bf16(__uint_as_float(w_[3] << 16) * qc, __uint_as_float(w_[3] & 0xffff0000u) * qc);
        *(u32x4*)(QN + (crow + 8 * k) * 64 + ccol) = o_; } }
    G2_SYNC();
#undef G2_LOADPUT
#undef G2_SOLVE
#undef G2_GET
#undef G2_SYNC
}
constexpr int GC_OB = 0, GC_OP = 34816, GC_OPSZ = 46080, GC_TILE = 9216;
__device__ void gdn_chain(const Params& p, unsigned char* ldsg, int bh) {
    unsigned char* ws = p.ws;
    LAS unsigned char* lds = (LAS unsigned char*)ldsg;
    const int tid = opaque_tid(), lane = tid & 63, wid = __builtin_amdgcn_readfirstlane(tid >> 6), r = lane & 15, q4 = lane >> 4, ct = wid & 3;
    const int h = bh >> 4, b = bh & 15;
    const bf16_t* __restrict__ HB = (const bf16_t*)(ws + WS_HB); const float* __restrict__ gnw = p.in[16];
    LAS float* obuf = (LAS float*)(lds + GC_OB);
    f32x4 S[4];
#pragma unroll
    for (int rt = 0; rt < 4; ++rt) S[rt] = (f32x4){0.f, 0.f, 0.f, 0.f};
    const bf16_t* __restrict__ zb = HB + ((size_t)((40 + h) * 16 + b) * SQ) * 64;
    bf16_t* __restrict__ mix = (bf16_t*)(ws + WS_ACT) + (size_t)b * SQ * 1024 + 512 + h * 64;
    const float* __restrict__ EGLb = (const float*)(ws + WS_EGL) + bh * 64;
    const int ltid = tid - 256;
    u32x4 lr[10];
#define GC_LOAD(n) do { _Pragma("unroll") for (int i = 0; i < 10; ++i) { const int e = ltid + 256 * i, tile = e >> 9, row = (e >> 3) & 63, ch = e & 7; \
        const size_t toff = tile == 0 ? WS_KN : tile == 1 ? WS_QN : tile == 2 ? WS_QKM : tile == 3 ? WS_KDT : WS_VB; \
        lr[i] = *(const u32x4*)((const bf16_t*)(ws + toff) + ((size_t)bh * 64 + (n)) * 4096 + row * 64 + ch * 8); } } while (0)
#define GC_STORE(n) do { _Pragma("unroll") for (int i = 0; i < 10; ++i) { const int e = ltid + 256 * i, tile = e >> 9, row = (e >> 3) & 63, ch = e & 7; \
        *(LAS u32x4*)(lds + GC_OP + ((n) & 1) * GC_OPSZ + tile * GC_TILE + row * 144 + ch * 16) = lr[i]; } } while (0)
#define LDP(tile, row, kc) __builtin_bit_cast(bf16x8, (u32x4){ ((const LAS u32x2*)(opb + (tile) * GC_TILE + (row) * 144 + (32 * (kc) + 4 * q4) * 2))[0].x, ((const LAS u32x2*)(opb + (tile) * GC_TILE + (row) * 144 + (32 * (kc) + 4 * q4) * 2))[0].y, \
                                                        ((const LAS u32x2*)(opb + (tile) * GC_TILE + (row) * 144 + (32 * (kc) + 16 + 4 * q4) * 2))[0].x, ((const LAS u32x2*)(opb + (tile) * GC_TILE + (row) * 144 + (32 * (kc) + 16 + 4 * q4) * 2))[0].y })
    __syncthreads();
    float egl = 0.f;
    if (wid >= 4) { GC_LOAD(0); GC_STORE(0); GC_LOAD(1); } else egl = EGLb[0];
    __syncthreads();
#pragma unroll 1
    for (int cc = 0; cc <= 64; ++cc) {
        if (wid < 4) {
            if (cc < 64) {
                LAS float* ob = obuf + (cc & 1) * 64 * 68;
                const LAS unsigned char* opb = lds + GC_OP + (cc & 1) * GC_OPSZ;
                const float egl_c = egl; if (cc < 63) egl = EGLb[cc + 1];
                bf16x8 sb[2], vb[2];
#pragma unroll
                for (int kc = 0; kc < 2; ++kc) { u32x4 pk; pk.x = cvt_pk_bf16(S[2 * kc][0], S[2 * kc][1]); pk.y = cvt_pk_bf16(S[2 * kc][2], S[2 * kc][3]); pk.z = cvt_pk_bf16(S[2 * kc + 1][0], S[2 * kc + 1][1]); pk.w = cvt_pk_bf16(S[2 * kc + 1][2], S[2 * kc + 1][3]); sb[kc] = __builtin_bit_cast(bf16x8, pk); }
                f32x4 vn[4];
#pragma unroll
                for (int rt = 0; rt < 4; ++rt) {
                    f32x4 a = (f32x4){0.f, 0.f, 0.f, 0.f};
                    a = MFMA16(LDP(0, 16 * rt + r, 0), sb[0], a); a = MFMA16(LDP(0, 16 * rt + r, 1), sb[1], a);
#pragma unroll
                    for (int jj = 0; jj < 4; ++jj) vn[rt][jj] = bf2f(*(const LAS bf16_t*)(opb + 4 * GC_TILE + (16 * rt + 4 * q4 + jj) * 144 + (16 * ct + r) * 2)) - a[jj];
                }
#pragma unroll
                for (int kc = 0; kc < 2; ++kc) { u32x4 pk; pk.x = cvt_pk_bf16(vn[2 * kc][0], vn[2 * kc][1]); pk.y = cvt_pk_bf16(vn[2 * kc][2], vn[2 * kc][3]); pk.z = cvt_pk_bf16(vn[2 * kc + 1][0], vn[2 * kc + 1][1]); pk.w = cvt_pk_bf16(vn[2 * kc + 1][2], vn[2 * kc + 1][3]); vb[kc] = __builtin_bit_cast(bf16x8, pk); }
#pragma unroll
                for (int rt = 0; rt < 4; ++rt) {
                    f32x4 a = (f32x4){0.f, 0.f, 0.f, 0.f};
                    a = MFMA16(LDP(1, 16 * rt + r, 0), sb[0], a); a = MFMA16(LDP(1, 16 * rt + r, 1), sb[1], a);
                    a = MFMA16(LDP(2, 16 * rt + r, 0), vb[0], a); a = MFMA16(LDP(2, 16 * rt + r, 1), vb[1], a);
#pragma unroll
                    for (int jj = 0; jj < 4; ++jj) ob[(16 * rt + 4 * q4 + jj) * 68 + 16 * ct + r] = a[jj];
                }
#pragma unroll
                for (int rt = 0; rt < 4; ++rt) {
                    f32x4 a = S[rt] * egl_c;
                    a = MFMA16(LDP(3, 16 * rt + r, 0), vb[0], a); a = MFMA16(LDP(3, 16 * rt + r, 1), vb[1], a);
                    S[rt] = a;
                }
            }
        } else {
            if (cc + 1 < 64) GC_STORE(cc + 1);
            if (cc + 2 < 64) GC_LOAD(cc + 2);
            if (cc >= 1) {
                const LAS float* ob = obuf + ((cc - 1) & 1) * 64 * 68;
                const int row = 16 * (wid - 4) + (lane >> 2), qd = lane & 3, s = (cc - 1) * 64 + row;
                const u32x4 z0 = *(const u32x4*)(zb + (size_t)s * 64 + 16 * qd), z1 = *(const u32x4*)(zb + (size_t)s * 64 + 16 * qd + 8);
                f32x4 v[4]; float ss = 0.f;
#pragma unroll
                for (int i = 0; i < 4; ++i) { v[i] = *(const LAS f32x4*)(ob + row * 68 + 16 * qd + 4 * i); ss += v[i][0] * v[i][0] + v[i][1] * v[i][1] + v[i][2] * v[i][2] + v[i][3] * v[i][3]; }
                ss += __shfl_xor(ss, 1); ss += __shfl_xor(ss, 2);
                const float rstd = rsqrtf(ss * (1.f / 64.f) + 1e-6f);
                const unsigned zw[8] = {z0.x, z0.y, z0.z, z0.w, z1.x, z1.y, z1.z, z1.w};
                unsigned ow[8];
#pragma unroll
                for (int i = 0; i < 8; ++i) { const float za = bf2f((bf16_t)(zw[i] & 0xffff)), zc = bf2f((bf16_t)(zw[i] >> 16));
                    const float a = v[i >> 1][(i & 1) * 2] * rstd * gnw[16 * qd + 2 * i] * siluf_(za), c = v[i >> 1][(i & 1) * 2 + 1] * rstd * gnw[16 * qd + 2 * i + 1] * siluf_(zc);
                    ow[i] = cvt_pk_bf16(a, c); }
                u32x4 w0, w1; w0.x = ow[0]; w0.y = ow[1]; w0.z = ow[2]; w0.w = ow[3]; w1.x = ow[4]; w1.y = ow[5]; w1.z = ow[6]; w1.w = ow[7];
                *(u32x4*)(mix + (size_t)s * 1024 + 16 * qd) = w0; *(u32x4*)(mix + (size_t)s * 1024 + 16 * qd + 8) = w1;
            }
        }
        __syncthreads();
    }
#undef LDP
#undef GC_LOAD
#undef GC_STORE
}
__device__ void cmp_stage2(const Params& p, unsigned char* ldsg) {
    unsigned char* ws = p.ws;
    const int tid = opaque_tid(), lane = tid & 63, wid = __builtin_amdgcn_readfirstlane(tid >> 6), G = gridDim.x;
    float* w2s = (float*)ldsg;
    for (int e = tid; e < 2 * 128 * 64; e += 512) w2s[e] = (e < 8192) ? p.in[9][e] : p.in[12][e - 8192];
    __syncthreads();
    const bf16_t* HID = (const bf16_t*)(ws + WS_HID); bf16_t* KC = (bf16_t*)(ws + WS_KC); bf16_t* VCT = (bf16_t*)(ws + WS_VCT);
    for (int r8 = blockIdx.x * 8 + wid; r8 < 2048; r8 += G * 8) {
        const int row0 = r8 * 8, isv = row0 >> 13, hb = (row0 >> 8) & 31, n0 = row0 & 255;
        const float* w = w2s + isv * 8192;
        float acc[8]; float h0[8], h1[8];
#pragma unroll
        for (int k = 0; k < 8; ++k) { const bf16_t* hr = HID + (size_t)(row0 + k) * 128; h0[k] = bf2f(hr[lane]); h1[k] = bf2f(hr[64 + lane]); acc[k] = 0.f; }
#pragma unroll 4
        for (int cc = 0; cc < 64; ++cc) { const float wa = w[cc * 64 + lane], wb = w[(64 + cc) * 64 + lane];
#pragma unroll
            for (int k = 0; k < 8; ++k) acc[k] += RDLANE(h0[k], cc) * wa + RDLANE(h1[k], cc) * wb; }
        if (n0 == 248) acc[7] = 0.f;
        if (!isv) {
#pragma unroll
            for (int k = 0; k < 8; ++k) KC[((size_t)hb * 256 + n0 + k) * 64 + lane] = f2bf(acc[k]);
        } else { u32x4 wv; wv.x = cvt_pk_bf16(acc[0], acc[1]); wv.y = cvt_pk_bf16(acc[2], acc[3]); wv.z = cvt_pk_bf16(acc[4], acc[5]); wv.w = cvt_pk_bf16(acc[6], acc[7]);
            *(u32x4*)(VCT + ((size_t)hb * 64 + lane) * 256 + n0) = wv; }
    }
    __syncthreads();
}
__device__ void sc_conv(const Params& p) {
    unsigned char* ws = p.ws;
    const bf16_t* __restrict__ SC = (const bf16_t*)(ws + WS_SC); bf16_t* __restrict__ Y = (bf16_t*)(ws + WS_ACT); const float* __restrict__ cw = p.in[19];
#pragma unroll 4
    for (size_t e = (size_t)blockIdx.x * 512 + opaque_tid(); e < (size_t)T_ * 128; e += (size_t)gridDim.x * 512) {
        const int t = (int)(e >> 7), c8 = (int)(e & 127) * 8, s = t & 4095;
        float acc[8];
#pragma unroll
        for (int i = 0; i < 8; ++i) acc[i] = 0.f;
#pragma unroll
        for (int j = 0; j < 3; ++j) { const int d = 2 - j; if (s - d >= 0) {
                const u32x4 cg = *(const u32x4*)(SC + (size_t)(t - d) * 3072 + 1024 + c8), uu = *(const u32x4*)(SC + (size_t)(t - d) * 3072 + 2048 + c8);
                const unsigned cgw[4] = {cg.x, cg.y, cg.z, cg.w}, uw[4] = {uu.x, uu.y, uu.z, uu.w};
#pragma unroll
                for (int i = 0; i < 8; ++i) { const float cv = bf2f((bf16_t)((cgw[i >> 1] >> ((i & 1) * 16)) & 0xffff)), uv = bf2f((bf16_t)((uw[i >> 1] >> ((i & 1) * 16)) & 0xffff)); acc[i] += cw[j * 1024 + c8 + i] * bf2f(f2bf(cv * uv)); } } }
        const u32x4 bg = *(const u32x4*)(SC + (size_t)t * 3072 + c8); const unsigned bw[4] = {bg.x, bg.y, bg.z, bg.w};
        u32x4 w; unsigned ow[4];
#pragma unroll
        for (int i = 0; i < 4; ++i) { const float b0 = bf2f((bf16_t)(bw[i] & 0xffff)), b1 = bf2f((bf16_t)(bw[i] >> 16)); ow[i] = cvt_pk_bf16(b0 * acc[2 * i], b1 * acc[2 * i + 1]); }
        w.x = ow[0]; w.y = ow[1]; w.z = ow[2]; w.w = ow[3];
        *(u32x4*)(Y + (size_t)t * 1024 + c8) = w;
    }
}
__device__ void final_norm(const Params& p) {
    const int lane = opaque_tid() & 63, gw = blockIdx.x * 8 + __builtin_amdgcn_readfirstlane(opaque_tid() >> 6), nw = gridDim.x * 8; const float* w = p.in[27];
    const float* ssq = (const float*)(p.ws + WS_SSQ) + (size_t)5 * T_; const bf16_t* __restrict__ XS = (const bf16_t*)(p.ws + WS_ACT2);
    f32x4 wv[4];
#pragma unroll
    for (int i = 0; i < 4; ++i) wv[i] = *(const f32x4*)(w + i * 256 + lane * 4);
    for (int r = gw; r < T_; r += 2 * nw) {
        const int r2 = r + nw;
        const float ra = rsqrtf(ssq[r] * (1.f / 1024.f) + 1e-6f), rb = rsqrtf(ssq[r2] * (1.f / 1024.f) + 1e-6f);
        u32x2 va[4], vb[4];
#pragma unroll
        for (int i = 0; i < 4; ++i) { va[i] = *(const u32x2*)(XS + (size_t)r * 1024 + i * 256 + lane * 4); vb[i] = *(const u32x2*)(XS + (size_t)r2 * 1024 + i * 256 + lane * 4); }
#pragma unroll
        for (int i = 0; i < 4; ++i) {
            const f32x4 xa = (f32x4){__uint_as_float(va[i].x << 16), __uint_as_float(va[i].x & 0xffff0000u), __uint_as_float(va[i].y << 16), __uint_as_float(va[i].y & 0xffff0000u)};
            const f32x4 xb = (f32x4){__uint_as_float(vb[i].x << 16), __uint_as_float(vb[i].x & 0xffff0000u), __uint_as_float(vb[i].y << 16), __uint_as_float(vb[i].y & 0xffff0000u)};
            *(f32x4*)(p.out + (size_t)r * 1024 + i * 256 + lane * 4) = xa * ra * wv[i]; *(f32x4*)(p.out + (size_t)r2 * 1024 + i * 256 + lane * 4) = xb * rb * wv[i]; }
    }
}
__device__ void rope_pass(const Params& p) {
    unsigned char* ws = p.ws; bf16_t* HB = (bf16_t*)(ws + WS_HB); const float* __restrict__ COS = (const float*)(ws + WS_COS); const float* __restrict__ SIN = (const float*)(ws + WS_SIN);
    const size_t total = (size_t)12 * T_ * 4, stride = (size_t)gridDim.x * 512;
#pragma unroll 1
    for (size_t e0 = (size_t)blockIdx.x * 512 + opaque_tid(); e0 < total; e0 += 4 * stride) {
        u32x4 a[4], bq[4]; f32x4 c0[4], c1[4], s0[4], s1[4]; bf16_t* ptr[4]; float qs[4]; bool ok[4];
#pragma unroll
        for (int k = 0; k < 4; ++k) { const size_t e = e0 + k * stride; ok[k] = e < total; const size_t ee = ok[k] ? e : e0;
            const int ch = (int)(ee & 3); const size_t row = ee >> 2; const int hi = (int)(row >> 16), tokr = (int)(row & 65535);
            const int Hd = hi < 8 ? hi : hi + 4; qs[k] = hi < 8 ? 0.125f * LOG2E : 1.f;
            ptr[k] = HB + ((size_t)Hd * T_ + tokr) * 64 + ch * 8;
            a[k] = *(const u32x4*)ptr[k]; bq[k] = *(const u32x4*)(ptr[k] + 32);
            c0[k] = *(const f32x4*)(COS + (size_t)tokr * 32 + ch * 8); c1[k] = *(const f32x4*)(COS + (size_t)tokr * 32 + ch * 8 + 4);
            s0[k] = *(const f32x4*)(SIN + (size_t)tokr * 32 + ch * 8); s1[k] = *(const f32x4*)(SIN + (size_t)tokr * 32 + ch * 8 + 4); }
#pragma unroll
        for (int k = 0; k < 4; ++k) {
            const unsigned aw[4] = {a[k].x, a[k].y, a[k].z, a[k].w}, bw[4] = {bq[k].x, bq[k].y, bq[k].z, bq[k].w};
            const float cw8[8] = {c0[k][0], c0[k][1], c0[k][2], c0[k][3], c1[k][0], c1[k][1], c1[k][2], c1[k][3]}, sw8[8] = {s0[k][0], s0[k][1], s0[k][2], s0[k][3], s1[k][0], s1[k][1], s1[k][2], s1[k][3]};
            float o1[8], o2[8];
#pragma unroll
            for (int i = 0; i < 8; ++i) { const float x1 = bf2f((bf16_t)((aw[i >> 1] >> ((i & 1) * 16)) & 0xffff)), x2 = bf2f((bf16_t)((bw[i >> 1] >> ((i & 1) * 16)) & 0xffff));
                o1[i] = (x1 * cw8[i] - x2 * sw8[i]) * qs[k]; o2[i] = (x2 * cw8[i] + x1 * sw8[i]) * qs[k]; }
            u32x4 wa, wb; wa.x = cvt_pk_bf16(o1[0], o1[1]); wa.y = cvt_pk_bf16(o1[2], o1[3]); wa.z = cvt_pk_bf16(o1[4], o1[5]); wa.w = cvt_pk_bf16(o1[6], o1[7]);
            wb.x = cvt_pk_bf16(o2[0], o2[1]); wb.y = cvt_pk_bf16(o2[2], o2[3]); wb.z = cvt_pk_bf16(o2[4], o2[5]); wb.w = cvt_pk_bf16(o2[6], o2[7]);
            if (ok[k]) { *(u32x4*)ptr[k] = wa; *(u32x4*)(ptr[k] + 32) = wb; }
        }
    }
}
constexpr int NPHASE = 26;
template <int PH>
__device__ __forceinline__ void run_phase(const Params& p, unsigned char* lds) {
    unsigned char* ws = p.ws;
    const int G = gridDim.x, bid = blockIdx.x, tid = opaque_tid(), lane = tid & 63, wid = __builtin_amdgcn_readfirstlane(tid >> 6);
    const int gw = bid * 8 + wid, nw = G * 8;
    LAS unsigned char* ldsl = (LAS unsigned char*)lds;
    bf16_t* ACT = (bf16_t*)(ws + WS_ACT);
    constexpr int layer = PH >= 14 ? 1 : 0;
    float* SSQ = (float*)(ws + WS_SSQ);
#define GEMM_RUN(EPI, E, Aptr, Bptr, M_, N_, K_, lda_, rot) do { pg8::Gemm g_{(const bf16_t*)(Aptr), (const bf16_t*)(Bptr), (M_), (N_), (K_), (lda_)}; pg8::StaticOrder S_; S_.init((M_), (N_), G, (bid + (rot)) % G); \
        pg8::gemm_phase<EPI>(ldsl, g_, S_, E); } while (0)
    if constexpr (PH == 0) phase_prep(p, lds);
    else if constexpr (PH == 1) {
        { pg8::EpiInproj E{(bf16_t*)(ws + WS_HB), (float*)(ws + WS_SM)};
          GEMM_RUN(pg8::EpiInproj, E, ACT, ws + WS_WIN, T_, 3328, 1024, 1024, 0); }
        { pg8::EpiBf16 E{(bf16_t*)(ws + WS_VT), T_, 1.f, 0, nullptr}; GEMM_RUN(pg8::EpiBf16, E, ws + WS_WVT, ACT, 256, T_, 1024, 1024, 0); }
        for (int l = 0; l < 2; ++l) {
            { pg8::EpiBf16 E{(bf16_t*)(ws + WS_KMEM) + (size_t)l * 4096 * 512, 512, 1.f, 0, nullptr}; GEMM_RUN(pg8::EpiBf16, E, ws + WS_MEMN, (bf16_t*)(ws + WS_WKM) + (size_t)l * 512 * 1024, 4096, 512, 1024, 1024, 64 * l); }
            { pg8::EpiBf16 E{(bf16_t*)(ws + WS_VMT) + (size_t)l * 512 * 4096, 4096, 1.f, 0, nullptr}; GEMM_RUN(pg8::EpiBf16, E, (bf16_t*)(ws + WS_WVM) + (size_t)l * 512 * 1024, ws + WS_MEMN, 512, 4096, 1024, 1024, 64 * l + 32); }
        }
    } else if constexpr (PH == 2) {
        { pg8::EpiCmp1 E{(bf16_t*)(ws + WS_HID), (const float*)(ws + WS_BIAS1)};
          GEMM_RUN(pg8::EpiCmp1, E, (bf16_t*)(ws + WS_HB) + (size_t)8 * 16 * SQ * 64, ws + WS_WCMP1, 16384, 256, 2048, 1024, 0); }
        gdn_g1(p, (gw + 64 * 8) % nw, nw, lane);
        rope_pass(p);
    } else if constexpr (PH == 3) {
        cmp_stage2(p, lds);
        LAS float* Aw = (LAS float*)(ldsl + wid * 16640);
        for (int cid = gw; cid < 8192; cid += nw) gdn_g2(p, Aw, cid, lane);
    } else if constexpr (PH == 4) {
    } else if constexpr (PH == 5) {
        for (int e = bid * 512 + tid; e < 6 * T_; e += G * 512) SSQ[e] = 0.f;
        if (bid < 128) gdn_chain(p, lds, bid);
        unsigned* ctr = (unsigned*)(ws + WS_CTL);
        LAS int* s_item = (LAS int*)(ldsl + LDS_BYTES - 16);
        for (;;) {
            if (tid == 0) *s_item = (int)atomicAdd(ctr, 1u);
            __syncthreads();
            const int item = __builtin_amdgcn_readfirstlane(*s_item);
            __syncthreads();
            if (item >= 4096) break;
            nsa_item(p, lds, item);
        }
    } else if constexpr (PH == 6) { pg8::EpiResid<false> E{p.in[0], 1024, (bf16_t*)(ws + WS_ACT2), SSQ}; GEMM_RUN(pg8::EpiResid<false>, E, ACT, ws + WS_WOUT, T_, 1024, 1024, 1024, 0); }
    else if constexpr (PH == 8 || PH == 19) { pg8::EpiBf16 E{(bf16_t*)(ws + WS_QX), 512, 0.08838834764831845f * LOG2E, 0, SSQ + (size_t)(layer ? 3 : 0) * T_}; GEMM_RUN(pg8::EpiBf16, E, ws + WS_ACT2, (bf16_t*)(ws + WS_WQ) + (size_t)layer * 512 * 1024, T_, 512, 1024, 1024, 0); }
    else if constexpr (PH == 9 || PH == 20) { for (int blk = bid; blk < 256; blk += G) xattn_block(p, lds, blk, layer); }
    else if constexpr (PH == 10 || PH == 21) { pg8::EpiResid<true> E{ws + WS_ACT2, 1024, ACT, SSQ + (size_t)(layer ? 4 : 1) * T_}; GEMM_RUN(pg8::EpiResid<true>, E, ws + WS_OX, (bf16_t*)(ws + WS_WO) + (size_t)layer * 1024 * 512, T_, 1024, 512, 512, 0); }
    else if constexpr (PH == 12 || PH == 23) { pg8::EpiBf16 E{(bf16_t*)(ws + WS_H1), 4096, 1.f, 1, SSQ + (size_t)(layer ? 4 : 1) * T_}; GEMM_RUN(pg8::EpiBf16, E, ACT, (bf16_t*)(ws + WS_W1) + (size_t)layer * 4096 * 1024, T_, 4096, 1024, 1024, 0); }
    else if constexpr (PH == 13) { pg8::EpiResid<true> E{ACT, 1024, (bf16_t*)(ws + WS_ACT2), SSQ + (size_t)2 * T_}; GEMM_RUN(pg8::EpiResid<true>, E, ws + WS_H1, (bf16_t*)(ws + WS_W2), T_, 1024, 4096, 4096, 0); }
    else if constexpr (PH == 24) { pg8::EpiResid<true> E{ACT, 1024, (bf16_t*)(ws + WS_ACT2), SSQ + (size_t)5 * T_}; GEMM_RUN(pg8::EpiResid<true>, E, ws + WS_H1, (bf16_t*)(ws + WS_W2) + (size_t)1024 * 4096, T_, 1024, 4096, 4096, 0); }
    else if constexpr (PH == 15) { pg8::EpiBf16 E{(bf16_t*)(ws + WS_SC), 3072, 1.f, 0, SSQ + (size_t)2 * T_}; GEMM_RUN(pg8::EpiBf16, E, ws + WS_ACT2, ws + WS_WSCIN, T_, 3072, 1024, 1024, 0); }
    else if constexpr (PH == 16) sc_conv(p);
    else if constexpr (PH == 17) { pg8::EpiResid<true> E{ws + WS_ACT2, 1024, (bf16_t*)(ws + WS_ACT2), SSQ + (size_t)3 * T_}; GEMM_RUN(pg8::EpiResid<true>, E, ACT, ws + WS_WSCOUT, T_, 1024, 1024, 1024, 0); }
    else if constexpr (PH == 25) final_norm(p);
#undef GEMM_RUN
}

#ifndef SINGLE_LAUNCH
#define SINGLE_LAUNCH 1
#endif
template <int PH>
__global__ void __launch_bounds__(512, 2) phase_kernel(Params p) {
    extern __shared__ __attribute__((aligned(16))) unsigned char lds[];
    run_phase<PH>(p, lds);
}

#define XB_TMO      128
#define XB_XCNT(j)  (256  + 64 * (j))
#define XB_XSUB(j)  (1280 + 64 * (j))
#define XB_XGEN(j)  (2304 + 64 * (j))
#define XB_TOP      3328
#define XB_TOPGEN   3392
#define XCD_BAR_WORDS 3456
#define XB_SPIN_CAP (1u << 18)
__device__ __forceinline__ unsigned xb_ld(unsigned* p)              { return __hip_atomic_load(p, __ATOMIC_RELAXED, __HIP_MEMORY_SCOPE_AGENT); }
__device__ __forceinline__ unsigned xb_add(unsigned* p, unsigned v) { return __hip_atomic_fetch_add(p, v, __ATOMIC_RELAXED, __HIP_MEMORY_SCOPE_AGENT); }
__device__ __forceinline__ unsigned xb_xcc_id() { return (unsigned)__builtin_amdgcn_s_getreg((3 << 11) | 20) & 0xFu; }
#define XB_SPIN(cond, bar) do { while (cond) { __builtin_amdgcn_s_sleep(1); } } while (0)
struct XcdBarrier { unsigned* bar; unsigned x; volatile LAS unsigned* st; };
__device__ __forceinline__ XcdBarrier xcd_barrier_post(unsigned* bar, volatile LAS unsigned* st) {
    XcdBarrier b; b.bar = bar; b.x = xb_xcc_id(); b.st = st;
    if (threadIdx.x == 0) (void)xb_add(&bar[XB_XCNT(b.x)], 1u);
    return b;
}
__device__ __forceinline__ void xcd_barrier_complete(unsigned* bar, unsigned x, unsigned& nloc, unsigned& nx) {
    const unsigned G = gridDim.x * gridDim.y * gridDim.z;
    unsigned sum, cnt, mine, sp = 0u;
    for (;;) {
        sum = 0u; cnt = 0u; mine = 0u;
#pragma unroll
        for (unsigned j = 0; j < 16; ++j) { const unsigned c = xb_ld(&bar[XB_XCNT(j)]); sum += c; cnt += (c > 0u) ? 1u : 0u; mine = (j == x) ? c : mine; }
        if (sum == G) break;
        __builtin_amdgcn_s_sleep(1);
        if ((++sp & 255u) == 0u) { if (xb_ld(&bar[XB_TMO])) break; if (sp > XB_SPIN_CAP) { atomicAdd(&bar[XB_TMO], 1u); break; } }
    }
    nloc = mine > 0u ? mine : 1u; nx = cnt > 0u ? cnt : 1u;
}
__device__ __forceinline__ void xcd_barrier(unsigned* bar_, volatile LAS unsigned* st_) {
    XcdBarrier b; b.bar = bar_; b.x = xb_xcc_id(); b.st = st_;
    asm volatile("s_waitcnt vmcnt(0)" ::: "memory");
    __syncthreads();
    if (threadIdx.x == 0) {
        unsigned* bar = b.bar;
        __builtin_amdgcn_s_waitcnt(0);
        unsigned nloc = b.st[0], nx = b.st[1];
        const unsigned old = xb_add(&bar[XB_XSUB(b.x)], 1u);
        const unsigned gen = old / nloc;
        if (old + 1u == (gen + 1u) * nloc) {
            __builtin_amdgcn_fence(__ATOMIC_RELEASE, "agent");
            asm volatile("s_waitcnt vmcnt(0)" ::: "memory");
            const unsigned og = xb_add(&bar[XB_TOP], 1u);
            const unsigned tg = og / nx;
            if (og + 1u == (tg + 1u) * nx) xb_add(&bar[XB_TOPGEN], 1u);
            else XB_SPIN(xb_ld(&bar[XB_TOPGEN]) == tg, bar);
            __builtin_amdgcn_fence(__ATOMIC_ACQUIRE, "agent");
            xb_add(&bar[XB_XGEN(b.x)], 1u);
            asm volatile("s_waitcnt vmcnt(0)" ::: "memory");
        } else {
            XB_SPIN(xb_ld(&bar[XB_XGEN(b.x)]) == gen, bar);
            __builtin_amdgcn_fence(__ATOMIC_ACQUIRE, "agent");
            asm volatile("s_waitcnt vmcnt(0)" ::: "memory");
        }
    }
    __syncthreads();
}
constexpr size_t WS_XBAR = 65536;

template <int LO, int HI>
__device__ __forceinline__ void run_range(const Params& p, unsigned char* lds, cg::grid_group& grid) {
    run_phase<LO>(p, lds);
    if constexpr (LO < HI) { grid.sync(); run_range<LO + 1, HI>(p, lds, grid); }
}
template <int PH>
__device__ __forceinline__ void run_all(const Params& p, unsigned char* lds, cg::grid_group& grid) {
    asm volatile("; PHASE_MARK %0" :: "n"(PH));
    run_phase<PH>(p, lds);
#ifdef PROBE_SYNCS
    if constexpr (PH == 0) { for (int q = 0; q < PROBE_SYNCS; ++q) grid.sync(); }
#endif
#ifdef PROBE_SET
    if constexpr (((PROBE_SET >> PH) & 1u) != 0u) { grid.sync(); run_phase<PH>(p, lds); }
#endif
#ifdef PROBE_LO
    if constexpr (PH == PROBE_HI) { grid.sync(); if (blockIdx.x == 0 && opaque_tid() == 0) ((unsigned*)(p.ws + WS_CTL))[0] = 0u; grid.sync(); run_range<PROBE_LO, PROBE_HI>(p, lds, grid); }
#endif
    if constexpr (PH + 1 < NPHASE) { if constexpr (PH == 0) grid.sync(); else if constexpr (PH != 4 && PH != 7 && PH != 11 && PH != 14 && PH != 18 && PH != 22) xcd_barrier((unsigned*)(p.ws + WS_XBAR), (volatile LAS unsigned*)((LAS unsigned char*)lds + LDS_BYTES - 32)); run_all<PH + 1>(p, lds, grid); }
}
__global__ void __launch_bounds__(512, 2) hybrid_fwd(Params p) {
    extern __shared__ __attribute__((aligned(16))) unsigned char lds[];
    cg::grid_group grid = cg::this_grid();
    volatile LAS unsigned* st = (volatile LAS unsigned*)((LAS unsigned char*)lds + LDS_BYTES - 32);
    if (threadIdx.x < 2) st[threadIdx.x] = 0u;
    __syncthreads();
    { const XcdBarrier b0 = xcd_barrier_post((unsigned*)(p.ws + WS_XBAR), st);
      if (threadIdx.x == 0) { unsigned nloc, nx; xcd_barrier_complete(b0.bar, b0.x, nloc, nx); st[0] = nloc; st[1] = nx; }
      __syncthreads(); }
    run_all<0>(p, lds, grid);
}
template <int PH> static void launch_phases(const Params& p, int grid, hipStream_t stream) {
    static bool attr_done = false;
    if (!attr_done) { (void)hipFuncSetAttribute((const void*)phase_kernel<PH>, hipFuncAttributeMaxDynamicSharedMemorySize, LDS_BYTES); attr_done = true; }
    hipLaunchKernelGGL(phase_kernel<PH>, dim3(grid), dim3(512), LDS_BYTES, stream, p);
    if constexpr (PH + 1 < NPHASE) launch_phases<PH + 1>(p, grid, stream);
}

extern "C" void kernel_launch(void* const* d_in, const int* in_sizes, int n_in, void* d_out, int out_size, void* d_ws, size_t ws_size, hipStream_t stream) {
    static int grid = 0;
    if (grid == 0) {
        if (n_in != 28 || ws_size < WS_END) { fprintf(stderr, "kernel_launch: unexpected n_in %d or ws_size %zu (need %zu)\n", n_in, ws_size, (size_t)WS_END); grid = -1; return; }
        int dev = 0, cus = 0;
        (void)hipGetDevice(&dev); (void)hipDeviceGetAttribute(&cus, hipDeviceAttributeMultiprocessorCount, dev);
        grid = cus;
    }
    if (grid < 0) return;
    Params p{};
    for (int i = 0; i < 28; ++i) p.in[i] = (const float*)d_in[i];
    p.out = (float*)d_out; p.ws = (unsigned char*)d_ws; p.ph_lo = 0; p.ph_hi = NPHASE;
#if SINGLE_LAUNCH
    static bool attr_done = false;
    if (!attr_done) { if (hipFuncSetAttribute((const void*)hybrid_fwd, hipFuncAttributeMaxDynamicSharedMemorySize, LDS_BYTES) != hipSuccess) fprintf(stderr, "kernel_launch: hipFuncSetAttribute failed\n"); attr_done = true; }
    (void)hipMemsetAsync((char*)d_ws + WS_XBAR, 0, 16384, stream);
    void* args[] = {&p};
    hipError_t e = hipLaunchCooperativeKernel((const void*)hybrid_fwd, dim3(grid), dim3(512), args, LDS_BYTES, stream);
    if (e != hipSuccess) fprintf(stderr, "cooperative launch failed: %s (grid %d)\n", hipGetErrorString(e), grid);
#else
    launch_phases<0>(p, grid, stream);
#endif
}
```

```cpp
#include <hip/hip_runtime.h>
#include <hip/hip_cooperative_groups.h>
#include <cstdio>
namespace cg = cooperative_groups;

#define LAS __attribute__((address_space(3)))
typedef unsigned short bf16_t;
typedef short bf16x8 __attribute__((ext_vector_type(8)));
typedef float f32x4 __attribute__((ext_vector_type(4)));
typedef unsigned u32x4 __attribute__((ext_vector_type(4)));
typedef unsigned u32x2 __attribute__((ext_vector_type(2)));
typedef unsigned long long u64;

constexpr int T_ = 65536, SQ = 4096;
constexpr size_t MiB = 1ull << 20;
constexpr size_t WS_CTL = 0, WS_BIAS1 = 4096, WS_EGL = 8192;
constexpr size_t WS_WIN = 1 * MiB, WS_WVT = 8 * MiB, WS_WCMP1 = 9 * MiB, WS_WOUT = 10 * MiB, WS_WSCIN = 12 * MiB, WS_WSCOUT = 18 * MiB;
constexpr size_t WS_WQ = 20 * MiB, WS_WKM = 22 * MiB, WS_WVM = 24 * MiB, WS_WO = 26 * MiB, WS_W1 = 28 * MiB, WS_W2 = 44 * MiB;
constexpr size_t WS_COS = 60 * MiB, WS_SIN = 68 * MiB, WS_MEMN = 76 * MiB, WS_KMEM = 84 * MiB, WS_VMT = 92 * MiB;
constexpr size_t WS_ACT = 100 * MiB, WS_VT = 228 * MiB, WS_SM = 260 * MiB, WS_HID = 276 * MiB, WS_KC = 280 * MiB, WS_VCT = 281 * MiB;
constexpr size_t WS_HB = 283 * MiB, WS_QN = 667 * MiB, WS_KN = 731 * MiB, WS_VB = 795 * MiB, WS_QKM = 859 * MiB, WS_KDT = 923 * MiB, WS_END = 987 * MiB;
constexpr size_t WS_ACT2 = WS_QKM, WS_SSQ = WS_HID;
constexpr size_t WS_H1 = WS_HB, WS_SC = WS_HB, WS_QX = WS_HB, WS_OX = WS_HB + 64 * MiB;
constexpr int LDS_BYTES = 143360;
constexpr float LOG2E = 1.4426950408889634f;

struct Params { const float* in[28]; float* out; unsigned char* ws; int ph_lo, ph_hi; };

__device__ __forceinline__ unsigned cvt_pk_bf16(float lo, float hi) { unsigned r; asm volatile("v_cvt_pk_bf16_f32 %0, %1, %2" : "=v"(r) : "v"(lo), "v"(hi)); return r; }
__device__ __forceinline__ bf16_t f2bf(float f) { return (bf16_t)(cvt_pk_bf16(f, 0.f) & 0xffffu); }
__device__ __forceinline__ float bf2f(bf16_t b) { return __uint_as_float(((unsigned)b) << 16); }
__device__ __forceinline__ float wave_sum(float v) {
#pragma unroll
    for (int o = 32; o >= 1; o >>= 1) v += __shfl_xor(v, o);
    return v; }
__device__ __forceinline__ float sigmoidf_(float x) { return __builtin_amdgcn_rcpf(1.f + __expf(-x)); }
__device__ __forceinline__ float siluf_(float x) { return x * __builtin_amdgcn_rcpf(1.f + __expf(-x)); }
__device__ __forceinline__ int opaque_tid() { int t = threadIdx.x; asm volatile("" : "+v"(t)); return t; }
#define RDLANE(v, i) __int_as_float(__builtin_amdgcn_readlane(__float_as_int(v), (i)))
#define MFMA16(a, b, c) __builtin_amdgcn_mfma_f32_16x16x32_bf16(a, b, c, 0, 0, 0)

namespace pg8 {
constexpr int BM = 256, BK = 64, HALF = 128, HTB = HALF * BK * 2, STAGE_BYTES = 8 * HTB, NXCD = 8, WGM = 8;
__device__ __forceinline__ int lds_byte(int r, int c) { const int st = (r >> 4) * 2 + (c >> 5), rr = r & 15, cc = c & 31, ob = rr * 64 + cc * 2; return st * 1024 + (ob ^ (((ob >> 9) & 1) << 5)); }
__device__ __forceinline__ void stage_rc(int b, int& R, int& C) { const int st = b / 1024, sb = b % 1024, swz = sb ^ (((sb >> 9) & 1) << 5); R = (st >> 1) * 16 + swz / 64; C = (st & 1) * 32 + (swz % 64) / 2; }
__device__ __forceinline__ int perm32(int rho) { const int n = rho >> 4, i = rho & 15; return 8 * (i >> 2) + 4 * n + (i & 3); }
struct Unit { int pm, pn; };
struct Gemm { const bf16_t* A; const bf16_t* Bt; int M, N, K, lda; };
struct StaticOrder {
    int nM, nN, nwg, G, c;
    __device__ void init(int M, int N, int G_, int c_) { nM = M / BM; nN = N / BM; nwg = nM * nN; G = G_; c = c_; }
    __device__ bool next(int i, Unit& u) const {
        const long L = (long)i * G + c; if (L >= nwg) return false;
        int wgid = (int)L; { const int q = nwg / NXCD, r = nwg % NXCD, xcd = wgid % NXCD, off = wgid / NXCD; wgid = (xcd < r ? xcd * (q + 1) : r * (q + 1) + (xcd - r) * q) + off; }
        const int nig = WGM * nN, gid = wgid / nig, fm = gid * WGM, gsz = (nM - fm) < WGM ? (nM - fm) : WGM;
        u.pm = fm + ((wgid % nig) % gsz); u.pn = (wgid % nig) / gsz; return true;
    }
};

template <class Epi>
__device__ __forceinline__ void gemm_phase(LAS unsigned char* lds, const Gemm g, const StaticOrder& S, const Epi& E) {
    const int tid = opaque_tid(), wid = __builtin_amdgcn_readfirstlane(tid >> 6), lane = tid & 63, wr = wid >> 2, wc = wid & 3, fr = lane & 15, fq = lane >> 4;
    const int K = g.K, nt = K / BK, lda = g.lda;
    unsigned voffA[2], voffB[2];
#pragma unroll
    for (int i = 0; i < 2; ++i) { int R, C; stage_rc(tid * 16 + i * 8192, R, C); const int Rb = Epi::PERM ? ((R & ~31) + perm32(R & 31)) : R;
        voffA[i] = (unsigned)(R * lda + C) * 2u; voffB[i] = (unsigned)(Rb * K + C) * 2u; }
    const size_t kstep = (size_t)(BK * 2);
    const size_t hstepA = (size_t)HALF * lda * 2, hstepB = (size_t)HALF * K * 2;
    const size_t tstepA = 2 * hstepA, tstepB = 2 * hstepB;
    const unsigned ldsw = (unsigned)wid * 1024u;
    const int aoff = lds_byte(wr * 64 + fr, fq * 8), boff = lds_byte(wc * 32 + fr, fq * 8);
#define PG8_SA(b, h) (((b) * 2 + (h)) * HTB)
#define PG8_SB(b, h) ((4 + (b) * 2 + (h)) * HTB)
#define PG8_STAGE(bufoff, gbase, voff) do { _Pragma("unroll") for (int _i = 0; _i < 2; ++_i) \
        __builtin_amdgcn_global_load_lds((const unsigned*)((const char*)(gbase) + (voff)[_i]), (LAS unsigned*)(lds + (bufoff) + ldsw + _i * 8192), 16, 0, 0); } while (0)
#define PG8_LDA(dst, b, h) do { _Pragma("unroll") for (int m = 0; m < 4; ++m) _Pragma("unroll") for (int k = 0; k < 2; ++k) dst[m][k] = *(const LAS bf16x8*)(lds + PG8_SA(b, h) + aoff + m * 2048 + k * 1024); } while (0)
#define PG8_LDB(dst, b, h) do { _Pragma("unroll") for (int n = 0; n < 2; ++n) _Pragma("unroll") for (int k = 0; k < 2; ++k) dst[n][k] = *(const LAS bf16x8*)(lds + PG8_SB(b, h) + boff + n * 2048 + k * 1024); } while (0)
#define PG8_MMA(ai, bj, At, Bt) do { __builtin_amdgcn_s_setprio(1); _Pragma("unroll") for (int m = 0; m < 4; ++m) _Pragma("unroll") for (int n = 0; n < 2; ++n) _Pragma("unroll") for (int k = 0; k < 2; ++k) \
        acc[ai][bj][m][n] = __builtin_amdgcn_mfma_f32_16x16x32_bf16(Bt[n][k], At[m][k], acc[ai][bj][m][n], 0, 0, 0); __builtin_amdgcn_s_setprio(0); } while (0)
#define PG8_WAIT_V(n) asm volatile("s_waitcnt vmcnt(" #n ")" ::: "memory")
#define PG8_WAIT_L(n) asm volatile("s_waitcnt lgkmcnt(" #n ")" ::: "memory")
#define PG8_BAR __builtin_amdgcn_s_barrier()
#define PG8_SCHED __builtin_amdgcn_sched_barrier(0)
    Unit cur, nxt; int ui = 0;
    if (!S.next(0, cur)) return;
    f32x4 acc[2][2][4][2];
#pragma unroll
    for (int a = 0; a < 2; ++a)
#pragma unroll
        for (int b = 0; b < 2; ++b)
#pragma unroll
            for (int m = 0; m < 4; ++m)
#pragma unroll
                for (int n = 0; n < 2; ++n) acc[a][b][m][n] = (f32x4){0.f, 0.f, 0.f, 0.f};
    bf16x8 At[4][2], B0[2][2], B1[2][2];
    const char* cA = (const char*)g.A + (size_t)cur.pm * tstepA; const char* cB = (const char*)g.Bt + (size_t)cur.pn * tstepB;
    PG8_STAGE(PG8_SB(0, 0), cB, voffB); PG8_STAGE(PG8_SA(0, 0), cA, voffA); PG8_STAGE(PG8_SB(0, 1), cB + hstepB, voffB); PG8_STAGE(PG8_SA(0, 1), cA + hstepA, voffA);
    if (wr == 1) PG8_BAR;
    PG8_WAIT_V(4); PG8_BAR;
    PG8_STAGE(PG8_SB(1, 0), cB + kstep, voffB); PG8_STAGE(PG8_SA(1, 0), cA + kstep, voffA); PG8_STAGE(PG8_SB(1, 1), cB + hstepB + kstep, voffB);
    PG8_WAIT_V(6); PG8_BAR;
    for (;;) {
        const bool has_next = S.next(ui + 1, nxt);
        const char* nA = has_next ? (const char*)g.A + (size_t)nxt.pm * tstepA : cA; const char* nB = has_next ? (const char*)g.Bt + (size_t)nxt.pn * tstepB : cB;
        for (int t = 0; t < nt; t += 2) {
            const bool last = (t == nt - 2);
            const char* a1 = cA + (size_t)(t + 1) * kstep;
            const char* a2 = last ? nA : cA + (size_t)(t + 2) * kstep; const char* b2 = last ? nB : cB + (size_t)(t + 2) * kstep;
            const char* a3 = a2 + kstep; const char* b3 = b2 + kstep;
            PG8_LDB(B0, 0, 0); PG8_SCHED; PG8_LDA(At, 0, 0); PG8_STAGE(PG8_SA(1, 1), a1 + hstepA, voffA);
            PG8_WAIT_L(8); PG8_BAR; PG8_WAIT_L(0); PG8_MMA(0, 0, At, B0); PG8_BAR; PG8_SCHED;
            PG8_LDB(B1, 0, 1); PG8_STAGE(PG8_SB(0, 0), b2, voffB);
            PG8_BAR; PG8_WAIT_L(0); PG8_MMA(0, 1, At, B1); PG8_BAR;
            PG8_LDA(At, 0, 1); PG8_STAGE(PG8_SA(0, 0), a2, voffA);
            PG8_BAR; PG8_WAIT_L(0); PG8_MMA(1, 0, At, B0); PG8_BAR; PG8_SCHED;
            PG8_STAGE(PG8_SB(0, 1), b2 + hstepB, voffB);
            PG8_WAIT_V(6); PG8_BAR; PG8_MMA(1, 1, At, B1); PG8_BAR;
            PG8_LDB(B0, 1, 0); PG8_SCHED; PG8_LDA(At, 1, 0); PG8_STAGE(PG8_SA(0, 1), a2 + hstepA, voffA);
            PG8_WAIT_L(8); PG8_BAR; PG8_WAIT_L(0); PG8_MMA(0, 0, At, B0); PG8_BAR; PG8_SCHED;
            PG8_LDB(B1, 1, 1); PG8_STAGE(PG8_SB(1, 0), b3, voffB);
            PG8_BAR; PG8_WAIT_L(0); PG8_MMA(0, 1, At, B1); PG8_BAR;
            PG8_LDA(At, 1, 1); PG8_STAGE(PG8_SA(1, 0), a3, voffA);
            PG8_BAR; PG8_WAIT_L(0); PG8_MMA(1, 0, At, B0); PG8_BAR; PG8_SCHED;
            PG8_STAGE(PG8_SB(1, 1), b3 + hstepB, voffB);
            PG8_WAIT_V(6); PG8_BAR; PG8_MMA(1, 1, At, B1); PG8_BAR;
        }
        E(acc, cur, wr, wc, fr, fq);
        if (!has_next) break;
#pragma unroll
        for (int a = 0; a < 2; ++a)
#pragma unroll
            for (int b = 0; b < 2; ++b)
#pragma unroll
                for (int m = 0; m < 4; ++m)
#pragma unroll
                    for (int n = 0; n < 2; ++n) acc[a][b][m][n] = (f32x4){0.f, 0.f, 0.f, 0.f};
        cur = nxt; cA = nA; cB = nB; ++ui;
    }
    PG8_WAIT_V(0);
    if (wr == 0) PG8_BAR;
    PG8_BAR;
#undef PG8_SA
#undef PG8_SB
#undef PG8_STAGE
#undef PG8_LDA
#undef PG8_LDB
#undef PG8_MMA
#undef PG8_WAIT_V
#undef PG8_WAIT_L
#undef PG8_BAR
#undef PG8_SCHED
}

struct EpiBf16 {
    static constexpr bool PERM = true;
    bf16_t* O; int ldc; float scale; int act; const float* ssq;
    __device__ __forceinline__ void operator()(const f32x4 (&acc)[2][2][4][2], const Unit& u, int wr, int wc, int fr, int fq) const {
        const int row0 = u.pm * BM + wr * 64 + fr, col0 = u.pn * BM + wc * 32 + 8 * fq;
        float rscv[2][4];
#pragma unroll
        for (int ai = 0; ai < 2; ++ai)
#pragma unroll
            for (int m = 0; m < 4; ++m) rscv[ai][m] = ssq ? ssq[row0 + ai * HALF + m * 16] : 0.f;
        asm volatile("" ::: "memory");
#pragma unroll
        for (int ai = 0; ai < 2; ++ai)
#pragma unroll
            for (int m = 0; m < 4; ++m) { bf16_t* rowp = O + (size_t)(row0 + ai * HALF + m * 16) * ldc + col0;
                const float rsc = ssq ? scale * rsqrtf(rscv[ai][m] * (1.f / 1024.f) + 1e-6f) : scale;
#pragma unroll
                for (int bj = 0; bj < 2; ++bj) { f32x4 v0 = acc[ai][bj][m][0] * rsc, v1 = acc[ai][bj][m][1] * rsc;
                    if (act == 1) {
#pragma unroll
                        for (int j = 0; j < 4; ++j) { const float a = fmaxf(v0[j], 0.f), b = fmaxf(v1[j], 0.f); v0[j] = a * a; v1[j] = b * b; } }
                    u32x4 w; w.x = cvt_pk_bf16(v0[0], v0[1]); w.y = cvt_pk_bf16(v0[2], v0[3]); w.z = cvt_pk_bf16(v1[0], v1[1]); w.w = cvt_pk_bf16(v1[2], v1[3]);
                    *(u32x4*)(rowp + bj * HALF) = w; } }
    }
};
template <bool BF>
struct EpiResid {
    static constexpr bool PERM = true;
    const void* base; int ldc; bf16_t* XB; float* ssq;
    __device__ __forceinline__ void operator()(const f32x4 (&acc)[2][2][4][2], const Unit& u, int wr, int wc, int fr, int fq) const {
        const int row0 = u.pm * BM + wr * 64 + fr, col0 = u.pn * BM + wc * 32 + 8 * fq;
#pragma unroll
        for (int ai = 0; ai < 2; ++ai) {
            f32x4 bv[4][2][2];
#pragma unroll
            for (int m = 0; m < 4; ++m)
#pragma unroll
                for (int bj = 0; bj < 2; ++bj) { const size_t o_ = (size_t)(row0 + ai * HALF + m * 16) * ldc + col0 + bj * HALF;
                    if (BF) { const u32x4 r_ = *(const u32x4*)((const bf16_t*)base + o_);
                        bv[m][bj][0] = (f32x4){__uint_as_float(r_.x << 16), __uint_as_float(r_.x & 0xffff0000u), __uint_as_float(r_.y << 16), __uint_as_float(r_.y & 0xffff0000u)};
                        bv[m][bj][1] = (f32x4){__uint_as_float(r_.z << 16), __uint_as_float(r_.z & 0xffff0000u), __uint_as_float(r_.w << 16), __uint_as_float(r_.w & 0xffff0000u)}; }
                    else { bv[m][bj][0] = *(const f32x4*)((const float*)base + o_); bv[m][bj][1] = *(const f32x4*)((const float*)base + o_ + 4); } }
            float sq[4];
#pragma unroll
            for (int m = 0; m < 4; ++m) { const size_t off = (size_t)(row0 + ai * HALF + m * 16) * ldc + col0; float s_ = 0.f;
#pragma unroll
                for (int bj = 0; bj < 2; ++bj) { const f32x4 v0 = bv[m][bj][0] + acc[ai][bj][m][0], v1 = bv[m][bj][1] + acc[ai][bj][m][1];
                    s_ += (v0[0] * v0[0] + v0[1] * v0[1]) + (v0[2] * v0[2] + v0[3] * v0[3]) + (v1[0] * v1[0] + v1[1] * v1[1]) + (v1[2] * v1[2] + v1[3] * v1[3]);
                    u32x4 w; w.x = cvt_pk_bf16(v0[0], v0[1]); w.y = cvt_pk_bf16(v0[2], v0[3]); w.z = cvt_pk_bf16(v1[0], v1[1]); w.w = cvt_pk_bf16(v1[2], v1[3]);
                    *(u32x4*)(XB + off + bj * HALF) = w; }
                sq[m] = s_; }
#pragma unroll
            for (int m = 0; m < 4; ++m) { float s_ = sq[m]; s_ += __shfl_xor(s_, 16); s_ += __shfl_xor(s_, 32); if (fq == 0) atomicAdd(ssq + row0 + ai * HALF + m * 16, s_); }
            asm volatile("" ::: "memory");
        }
    }
};
struct EpiCmp1 {
    static constexpr bool PERM = true;
    bf16_t* HID; const float* bias1;
    __device__ __forceinline__ void operator()(const f32x4 (&acc)[2][2][4][2], const Unit& u, int wr, int wc, int fr, int fq) const {
        const int isv = u.pm >= 32 ? 1 : 0; const int row0 = u.pm * BM + wr * 64 + fr, c0 = wc * 32 + 8 * fq;
        const f32x4 b0 = *(const f32x4*)(bias1 + isv * 128 + c0), b1 = *(const f32x4*)(bias1 + isv * 128 + c0 + 4);
#pragma unroll
        for (int ai = 0; ai < 2; ++ai)
#pragma unroll
            for (int m = 0; m < 4; ++m) { bf16_t* rowp = HID + (size_t)(row0 + ai * HALF + m * 16) * 128 + c0;
                f32x4 v0 = (isv ? acc[ai][1][m][0] : acc[ai][0][m][0]) + b0, v1 = (isv ? acc[ai][1][m][1] : acc[ai][0][m][1]) + b1;
#pragma unroll
                for (int j = 0; j < 4; ++j) { v0[j] = siluf_(v0[j]); v1[j] = siluf_(v1[j]); }
                u32x4 w; w.x = cvt_pk_bf16(v0[0], v0[1]); w.y = cvt_pk_bf16(v0[2], v0[3]); w.z = cvt_pk_bf16(v1[0], v1[1]); w.w = cvt_pk_bf16(v1[2], v1[3]);
                *(u32x4*)rowp = w; }
    }
};
struct EpiInproj {
    static constexpr bool PERM = true;
    bf16_t* HB; float* SM;
    __device__ __forceinline__ void operator()(const f32x4 (&acc)[2][2][4][2], const Unit& u, int wr, int wc, int fr, int fq) const {
        const int row0 = u.pm * BM + wr * 64 + fr;
        if (u.pn < 12) {
            const int wpar = wc & 1;
#pragma unroll
            for (int bj = 0; bj < 2; ++bj) {
                const int Hd = u.pn * 4 + bj * 2 + (wc >> 1);
                const unsigned off0 = (((unsigned)Hd * (unsigned)T_ + (unsigned)row0) * 64u + 32u * wpar + 8u * fq) * 2u;
#pragma unroll
                for (int ai = 0; ai < 2; ++ai)
#pragma unroll
                    for (int m = 0; m < 4; ++m) {
                        const f32x4 x1 = acc[ai][bj][m][0], x2 = acc[ai][bj][m][1];
                        u32x4 w; w.x = cvt_pk_bf16(x1[0], x1[1]); w.y = cvt_pk_bf16(x1[2], x1[3]); w.z = cvt_pk_bf16(x2[0], x2[1]); w.w = cvt_pk_bf16(x2[2], x2[3]);
                        *(u32x4*)((char*)HB + (size_t)(off0 + (unsigned)(ai * HALF + m * 16) * 128u)) = w;
                    }
            }
        } else if (wc == 0 || (wc == 1 && fq == 0)) {
#pragma unroll
            for (int n = 0; n < 2; ++n) {
                const int c0 = 32 * wc + 8 * fq + 4 * n;
#pragma unroll
                for (int ai = 0; ai < 2; ++ai)
#pragma unroll
                    for (int m = 0; m < 4; ++m) { const unsigned t = (unsigned)(row0 + ai * HALF + m * 16); *(f32x4*)((char*)SM + (size_t)((t * 64u + (unsigned)c0) * 4u)) = acc[ai][0][m][n]; }
            }
        }
    }
};
}

struct TJob { const float* src; bf16_t* dst; const float* rs; int K, N, ldw, map; };
__device__ __forceinline__ TJob get_job(const Params& p, int j) {
    unsigned char* ws = p.ws; TJob t; t.rs = nullptr; t.map = 0;
    switch (j) {
    case 0: t.src = p.in[6]; t.dst = (bf16_t*)(ws + WS_WIN); t.rs = p.in[3]; t.K = 1024; t.N = 3328; t.ldw = 3368; t.map = 1; break;
    case 1: t.src = p.in[6]; t.dst = (bf16_t*)(ws + WS_WVT); t.rs = p.in[3]; t.K = 1024; t.N = 256; t.ldw = 3368; t.map = 2; break;
    case 2: t.src = p.in[8]; t.dst = (bf16_t*)(ws + WS_WCMP1); t.K = 2048; t.N = 128; t.ldw = 128; break;
    case 3: t.src = p.in[11]; t.dst = (bf16_t*)(ws + WS_WCMP1) + 128 * 2048; t.K = 2048; t.N = 128; t.ldw = 128; break;
    case 4: t.src = p.in[17]; t.dst = (bf16_t*)(ws + WS_WOUT); t.K = 1024; t.N = 1024; t.ldw = 1024; break;
    case 5: t.src = p.in[18]; t.dst = (bf16_t*)(ws + WS_WSCIN); t.rs = p.in[3] + 1024; t.K = 1024; t.N = 3072; t.ldw = 3072; break;
    case 6: t.src = p.in[20]; t.dst = (bf16_t*)(ws + WS_WSCOUT); t.K = 1024; t.N = 1024; t.ldw = 1024; break;
    case 7: case 8: { const int l = j - 7; t.src = p.in[22] + (size_t)l * 1024 * 512; t.dst = (bf16_t*)(ws + WS_WQ) + (size_t)l * 512 * 1024; t.rs = p.in[4] + l * 1024; t.K = 1024; t.N = 512; t.ldw = 512; break; }
    case 9: case 10: { const int l = j - 9; t.src = p.in[23] + (size_t)l * 1024 * 1024; t.dst = (bf16_t*)(ws + WS_WKM) + (size_t)l * 512 * 1024; t.rs = p.in[21]; t.K = 1024; t.N = 512; t.ldw = 1024; break; }
    case 11: case 12: { const int l = j - 11; t.src = p.in[23] + (size_t)l * 1024 * 1024 + 512; t.dst = (bf16_t*)(ws + WS_WVM) + (size_t)l * 512 * 1024; t.rs = p.in[21]; t.K = 1024; t.N = 512; t.ldw = 1024; break; }
    case 13: case 14: { const int l = j - 13; t.src = p.in[24] + (size_t)l * 512 * 1024; t.dst = (bf16_t*)(ws + WS_WO) + (size_t)l * 1024 * 512; t.K = 512; t.N = 1024; t.ldw = 1024; break; }
    case 15: case 16: { const int l = j - 15; t.src = p.in[25] + (size_t)l * 1024 * 4096; t.dst = (bf16_t*)(ws + WS_W1) + (size_t)l * 4096 * 1024; t.rs = p.in[5] + l * 1024; t.K = 1024; t.N = 4096; t.ldw = 4096; break; }
    default: { const int l = j - 17; t.src = p.in[26] + (size_t)l * 4096 * 1024; t.dst = (bf16_t*)(ws + WS_W2) + (size_t)l * 1024 * 4096; t.K = 4096; t.N = 1024; t.ldw = 1024; break; }
    }
    return t;
}
constexpr int NJOBS = 19;
__device__ __forceinline__ int src_col(int map, int n) {
    if (map == 0) return n;
    if (map == 2) { const int vh = n >> 6, d = n & 63; return vh < 2 ? 896 + 64 * vh + d : 1152 + 64 * (vh - 2) + d; }
    if (n < 3072) { const int Hd = n >> 6, P = n & 63; const int d = P;
        int base;
        if (Hd < 8) base = 64 * Hd; else if (Hd < 10) base = 512 + 64 * (Hd - 8); else if (Hd < 12) base = 640 + 64 * (Hd - 10);
        else if (Hd < 14) base = 768 + 64 * (Hd - 12); else if (Hd < 16) base = 1024 + 64 * (Hd - 14); else if (Hd < 24) base = 1304 + 64 * (Hd - 16);
        else if (Hd < 32) base = 1816 + 64 * (Hd - 24); else if (Hd < 40) base = 2328 + 64 * (Hd - 32); else base = 2856 + 64 * (Hd - 40);
        return base + d; }
    const int c = n - 3072;
    if (c < 24) return 1280 + c; if (c < 32) return 2840 + (c - 24); if (c < 40) return 2848 + (c - 32);
    return -1;
}
__device__ __forceinline__ void rms_rows_bf16(const float* __restrict__ X, bf16_t* __restrict__ O, int rows, int gw, int nw, int lane) {
    for (int r = gw; r < rows; r += 2 * nw) {
        const int r2 = r + nw < rows ? r + nw : r;
        const float* xa = X + (size_t)r * 1024; const float* xb = X + (size_t)r2 * 1024; f32x4 va[4], vb[4]; float sa = 0.f, sb = 0.f;
#pragma unroll
        for (int i = 0; i < 4; ++i) { va[i] = *(const f32x4*)(xa + i * 256 + lane * 4); vb[i] = *(const f32x4*)(xb + i * 256 + lane * 4); }
#pragma unroll
        for (int i = 0; i < 4; ++i) { sa += va[i][0] * va[i][0] + va[i][1] * va[i][1] + va[i][2] * va[i][2] + va[i][3] * va[i][3]; sb += vb[i][0] * vb[i][0] + vb[i][1] * vb[i][1] + vb[i][2] * vb[i][2] + vb[i][3] * vb[i][3]; }
#pragma unroll
        for (int o = 32; o >= 1; o >>= 1) { sa += __shfl_xor(sa, o); sb += __shfl_xor(sb, o); }
        const float ra = rsqrtf(sa * (1.f / 1024.f) + 1e-6f), rb = rsqrtf(sb * (1.f / 1024.f) + 1e-6f);
#pragma unroll
        for (int i = 0; i < 4; ++i) { u32x2 w; w.x = cvt_pk_bf16(va[i][0] * ra, va[i][1] * ra); w.y = cvt_pk_bf16(va[i][2] * ra, va[i][3] * ra); *(u32x2*)(O + (size_t)r * 1024 + i * 256 + lane * 4) = w;
            w.x = cvt_pk_bf16(vb[i][0] * rb, vb[i][1] * rb); w.y = cvt_pk_bf16(vb[i][2] * rb, vb[i][3] * rb); *(u32x2*)(O + (size_t)r2 * 1024 + i * 256 + lane * 4) = w; }
    }
}
__device__ void phase_prep(const Params& p, unsigned char* lds) {
    const int tid = opaque_tid(), lane = tid & 63, wid = __builtin_amdgcn_readfirstlane(tid >> 6), G = gridDim.x, bid = blockIdx.x;
    const int gw = bid * 8 + wid, nw = G * 8;
    unsigned char* ws = p.ws;
    if (bid == 0 && tid < 64) ((unsigned*)(ws + WS_CTL))[tid] = 0u;
    {
        int tbase = 0;
        for (int j = 0; j < NJOBS; ++j) {
            const TJob jb = get_job(p, j);
            const int nnt = jb.N / 64, ntl = (jb.K / 64) * nnt;
            for (int lt = ((gw - tbase % nw) + nw) % nw; lt < ntl; lt += nw) {
                const int k0 = (lt / nnt) * 64, n0 = (lt % nnt) * 64;
                const int sc = src_col(jb.map, n0 + lane);
                const float* src = jb.src + (size_t)k0 * jb.ldw + (sc >= 0 ? sc : 0);
                float v[64];
#pragma unroll
                for (int k = 0; k < 64; ++k) v[k] = src[(size_t)k * jb.ldw];
                if (jb.rs) {
#pragma unroll
                    for (int k = 0; k < 64; ++k) v[k] *= jb.rs[k0 + k]; }
                if (sc < 0) {
#pragma unroll
                    for (int k = 0; k < 64; ++k) v[k] = 0.f; }
                bf16_t* dst = jb.dst + (size_t)(n0 + lane) * jb.K + k0;
#pragma unroll
                for (int k8 = 0; k8 < 8; ++k8) { u32x4 w; w.x = cvt_pk_bf16(v[8 * k8], v[8 * k8 + 1]); w.y = cvt_pk_bf16(v[8 * k8 + 2], v[8 * k8 + 3]); w.z = cvt_pk_bf16(v[8 * k8 + 4], v[8 * k8 + 5]); w.w = cvt_pk_bf16(v[8 * k8 + 6], v[8 * k8 + 7]); *(u32x4*)(dst + 8 * k8) = w; }
            }
            tbase += ntl;
        }
    }
    if (gw < 256) { const int c = gw, isv = c >> 7; const float* w1 = isv ? p.in[11] : p.in[8]; const float* pos = isv ? p.in[10] : p.in[7]; float s = 0.f;
        for (int k = lane; k < 2048; k += 64) s += pos[k] * w1[(size_t)k * 128 + (c & 127)];
        s = wave_sum(s); if (lane == 0) ((float*)(ws + WS_BIAS1))[c] = s; }
    { float* COS = (float*)(ws + WS_COS); float* SIN = (float*)(ws + WS_SIN); const int* pos = (const int*)p.in[2];
      for (int e = bid * 512 + tid; e < T_ * 32; e += G * 512) { const int t = e >> 5, i = e & 31; const float invf = powf(10000.f, -(float)(2 * i) / 64.f); const float ang = (float)pos[t] * invf; float sn, cs; sincosf(ang, &sn, &cs); COS[e] = cs; SIN[e] = sn; } }
    rms_rows_bf16(p.in[1], (bf16_t*)(ws + WS_MEMN), 4096, gw, nw, lane);
    rms_rows_bf16(p.in[0], (bf16_t*)(ws + WS_ACT), T_, gw, nw, lane);
}

template <int D, int KST>
__device__ __forceinline__ void qk_tile(const LAS bf16_t* Kt, const bf16x8 (&qf)[D / 32], f32x4 (&st)[4], int lane) {
    const int r = lane & 15, q4 = lane >> 4;
#pragma unroll
    for (int ti = 0; ti < 4; ++ti) {
        const int key = 32 * (ti >> 1) + (r >> 2) * 8 + 4 * (ti & 1) + (r & 3);
        f32x4 a = (f32x4){0.f, 0.f, 0.f, 0.f};
#pragma unroll
        for (int kc = 0; kc < D / 32; ++kc) { const bf16x8 kA = *(const LAS bf16x8*)(Kt + key * KST + 32 * (key >> 4) + 32 * kc + 8 * q4); a = MFMA16(kA, qf[kc], a); }
        st[ti] = a;
    }
}
template <int D, int VST>
__device__ __forceinline__ void pv_tile(const LAS bf16_t* Vt, const f32x4 (&pp)[4], f32x4 (&o)[D / 16], int lane) {
    const int r = lane & 15, q4 = lane >> 4;
#pragma unroll
    for (int c2 = 0; c2 < 2; ++c2) {
        u32x4 pk; pk.x = cvt_pk_bf16(pp[2 * c2][0], pp[2 * c2][1]); pk.y = cvt_pk_bf16(pp[2 * c2][2], pp[2 * c2][3]); pk.z = cvt_pk_bf16(pp[2 * c2 + 1][0], pp[2 * c2 + 1][1]); pk.w = cvt_pk_bf16(pp[2 * c2 + 1][2], pp[2 * c2 + 1][3]);
        const bf16x8 pB = __builtin_bit_cast(bf16x8, pk);
#pragma unroll
        for (int dt = 0; dt < D / 16; ++dt) { const bf16x8 vA = *(const LAS bf16x8*)(Vt + (16 * dt + r) * VST + 32 * c2 + 8 * q4); o[dt] = MFMA16(vA, pB, o[dt]); }
    }
}
template <int D, int VST>
__device__ __forceinline__ void softmax_pv(f32x4 (&st)[4], unsigned vm, float& mrun, float& lrun, f32x4 (&o)[D / 16], const LAS bf16_t* Vt, int lane) {
    float mx = -1e30f;
#pragma unroll
    for (int ti = 0; ti < 4; ++ti)
#pragma unroll
        for (int jj = 0; jj < 4; ++jj) if ((vm >> (ti * 4 + jj)) & 1u) mx = fmaxf(mx, st[ti][jj]);
    mx = fmaxf(mx, __shfl_xor(mx, 16)); mx = fmaxf(mx, __shfl_xor(mx, 32));
    const float mn = fmaxf(mrun, mx); const float alpha = __builtin_amdgcn_exp2f(mrun - mn); mrun = mn;
    float rs = 0.f;
#pragma unroll
    for (int ti = 0; ti < 4; ++ti)
#pragma unroll
        for (int jj = 0; jj < 4; ++jj) { const float pv = ((vm >> (ti * 4 + jj)) & 1u) ? __builtin_amdgcn_exp2f(st[ti][jj] - mn) : 0.f; st[ti][jj] = pv; rs += pv; }
    lrun = lrun * alpha + rs;
#pragma unroll
    for (int dt = 0; dt < D / 16; ++dt) o[dt] *= alpha;
    pv_tile<D, VST>(Vt, st, o, lane);
}

template <int D, int KST>
__device__ __forceinline__ void qk_tile_bias(const LAS bf16_t* Kt, const bf16x8 (&qf)[D / 32], f32x4 (&st)[4], float bias, int lane) {
    const int r = lane & 15, q4 = lane >> 4;
#pragma unroll
    for (int ti = 0; ti < 4; ++ti) {
        const int key = 32 * (ti >> 1) + (r >> 2) * 8 + 4 * (ti & 1) + (r & 3);
        f32x4 a = (f32x4){bias, bias, bias, bias};
#pragma unroll
        for (int kc = 0; kc < D / 32; ++kc) { const bf16x8 kA = *(const LAS bf16x8*)(Kt + key * KST + 32 * (key >> 4) + 32 * kc + 8 * q4); a = MFMA16(kA, qf[kc], a); }
        st[ti] = a;
    }
}
template <int D, int VST>
__device__ __forceinline__ void softmax_pv_fast(f32x4 (&st)[4], float& mrun, float& lrun, f32x4 (&o)[D / 16], const LAS bf16_t* Vt, int lane) {
    float mx = fmaxf(fmaxf(fmaxf(st[0][0], st[0][1]), fmaxf(st[0][2], st[0][3])), fmaxf(fmaxf(st[1][0], st[1][1]), fmaxf(st[1][2], st[1][3])));
    mx = fmaxf(mx, fmaxf(fmaxf(fmaxf(st[2][0], st[2][1]), fmaxf(st[2][2], st[2][3])), fmaxf(fmaxf(st[3][0], st[3][1]), fmaxf(st[3][2], st[3][3]))));
    mx = fmaxf(mx, __shfl_xor(mx, 16)); mx = fmaxf(mx, __shfl_xor(mx, 32));
    const float mn = fmaxf(mrun, mx); const float alpha = __builtin_amdgcn_exp2f(mrun - mn); const bool grow = mn > mrun; mrun = mn;
    f32x4 rs4 = (f32x4){0.f, 0.f, 0.f, 0.f};
#pragma unroll
    for (int ti = 0; ti < 4; ++ti) { const f32x4 d = st[ti] - mn; f32x4 e; e[0] = __builtin_amdgcn_exp2f(d[0]); e[1] = __builtin_amdgcn_exp2f(d[1]); e[2] = __builtin_amdgcn_exp2f(d[2]); e[3] = __builtin_amdgcn_exp2f(d[3]); st[ti] = e; rs4 += e; }
    lrun = lrun * alpha + (rs4[0] + rs4[1]) + (rs4[2] + rs4[3]);
    if (__any(grow)) {
#pragma unroll
        for (int dt = 0; dt < D / 16; ++dt) o[dt] *= alpha; }
    pv_tile<D, VST>(Vt, st, o, lane);
}

constexpr int NSA_KC = 0, NSA_VC = 38912, NSA_PS = 72704, NSA_IMP = 105472, NSA_MASK = 113664;
constexpr int KT72 = 64 * 72 + 128, KT136 = 64 * 136 + 128;
__device__ void nsa_item(const Params& p, unsigned char* ldsg, int item) {
    LAS unsigned char* lds = (LAS unsigned char*)ldsg;
    const int tid = opaque_tid(), lane = tid & 63, wid = __builtin_amdgcn_readfirstlane(tid >> 6), c = lane & 15, q4 = lane >> 4, tl = c >> 2, hh = c & 3;
    const int bg = item & 31, qt = 127 - (item >> 5), g = bg >> 4, b = bg & 15, t0 = qt * 32;
    const int t = t0 + 4 * wid + tl, h = 4 * g + hh, tok = b * SQ + t;
    unsigned char* ws = p.ws;
    const bf16_t* HB = (const bf16_t*)(ws + WS_HB); const float* SM = (const float*)(ws + WS_SM);
    bf16x8 qf[2];
    { const bf16_t* qrow = HB + ((size_t)(h * 16 + b) * SQ + t) * 64; qf[0] = *(const bf16x8*)(qrow + 8 * q4); qf[1] = *(const bf16x8*)(qrow + 32 + 8 * q4); }
    const float gate0 = sigmoidf_(SM[(size_t)tok * 64 + h * 3 + 0]), gate1 = sigmoidf_(SM[(size_t)tok * 64 + h * 3 + 1]), gate2 = sigmoidf_(SM[(size_t)tok * 64 + h * 3 + 2]);
    f32x4 outacc[4];
#pragma unroll
    for (int dt = 0; dt < 4; ++dt) outacc[dt] = (f32x4){0.f, 0.f, 0.f, 0.f};
    LAS bf16_t* Kc = (LAS bf16_t*)(lds + NSA_KC); LAS bf16_t* Vc = (LAS bf16_t*)(lds + NSA_VC);
    LAS float* PS = (LAS float*)(lds + NSA_PS); LAS float* IMP = (LAS float*)(lds + NSA_IMP); LAS u64* MASK = (LAS u64*)(lds + NSA_MASK);
    {
        int nvmax = t0 / 16 + 1; if (nvmax > 255) nvmax = 255;
        const int ntc = (nvmax + 63) >> 6;
        const bf16_t* KCg = (const bf16_t*)(ws + WS_KC) + (size_t)bg * 256 * 64; const bf16_t* VCg = (const bf16_t*)(ws + WS_VCT) + (size_t)bg * 64 * 256;
        { const int lr_ = tid >> 3, lc_ = (tid & 7) * 8; u32x4 kr[4], vr[4];
#pragma unroll
          for (int kt = 0; kt < 4; ++kt) if (kt < ntc) { kr[kt] = *(const u32x4*)(KCg + (size_t)(64 * kt + lr_) * 64 + lc_); vr[kt] = *(const u32x4*)(VCg + (size_t)lr_ * 256 + 64 * kt + lc_); }
#pragma unroll
          for (int kt = 0; kt < 4; ++kt) if (kt < ntc) { *(LAS u32x4*)(Kc + kt * KT72 + lr_ * 72 + 32 * (lr_ >> 4) + lc_) = kr[kt]; *(LAS u32x4*)(Vc + lr_ * 264 + 64 * kt + lc_) = vr[kt]; } }
        __syncthreads();
        const int nv = (t >= 31) ? (t - 31) / 16 + 1 : 0;
        f32x4 sc[4][4];
#pragma unroll
        for (int kt = 0; kt < 4; ++kt) {
            if (kt < ntc) qk_tile<64, 72>(Kc + kt * KT72, qf, sc[kt], lane);
            else {
#pragma unroll
                for (int ti = 0; ti < 4; ++ti) sc[kt][ti] = (f32x4){0.f, 0.f, 0.f, 0.f}; }
        }
        float mx = -1e30f;
#pragma unroll
        for (int kt = 0; kt < 4; ++kt)
#pragma unroll
            for (int ti = 0; ti < 4; ++ti)
#pragma unroll
                for (int jj = 0; jj < 4; ++jj) { const int n = 64 * kt + 32 * (ti >> 1) + 8 * q4 + 4 * (ti & 1) + jj; if (n < nv) mx = fmaxf(mx, sc[kt][ti][jj]); }
        mx = fmaxf(mx, __shfl_xor(mx, 16)); mx = fmaxf(mx, __shfl_xor(mx, 32));
        float ls = 0.f;
#pragma unroll
        for (int kt = 0; kt < 4; ++kt)
#pragma unroll
            for (int ti = 0; ti < 4; ++ti)
#pragma unroll
                for (int jj = 0; jj < 4; ++jj) { const int n = 64 * kt + 32 * (ti >> 1) + 8 * q4 + 4 * (ti & 1) + jj; const float pv = (n < nv) ? __builtin_amdgcn_exp2f(sc[kt][ti][jj] - mx) : 0.f; sc[kt][ti][jj] = pv; ls += pv; }
        ls += __shfl_xor(ls, 16); ls += __shfl_xor(ls, 32);
        const float inv = ls > 0.f ? 1.f / ls : 0.f;
#pragma unroll
        for (int kt = 0; kt < 4; ++kt)
#pragma unroll
            for (int ti = 0; ti < 4; ++ti)
#pragma unroll
                for (int jj = 0; jj < 4; ++jj) { const float pn = sc[kt][ti][jj] * inv; sc[kt][ti][jj] = pn; float v = pn; v += __shfl_xor(v, 1); v += __shfl_xor(v, 2);
                    if (hh == 0) PS[(4 * wid + tl) * 256 + 64 * kt + 32 * (ti >> 1) + 8 * q4 + 4 * (ti & 1) + jj] = v; }
        f32x4 o[4];
#pragma unroll
        for (int dt = 0; dt < 4; ++dt) o[dt] = (f32x4){0.f, 0.f, 0.f, 0.f};
#pragma unroll
        for (int kt = 0; kt < 4; ++kt) if (kt < ntc) pv_tile<64, 264>(Vc + 64 * kt, sc[kt], o, lane);
#pragma unroll
        for (int dt = 0; dt < 4; ++dt) outacc[dt] += o[dt] * gate0;
    }
    __syncthreads();
    const u32x4 kv_first = *(const u32x4*)(HB + (size_t)(12 + g) * 16 * SQ * 64 + (size_t)b * SQ * 64 + (size_t)(tid >> 3) * 64 + (tid & 7) * 8);
    const u32x4 vv_first = *(const u32x4*)((const bf16_t*)(ws + WS_VT) + (size_t)g * 64 * T_ + (size_t)b * SQ + (size_t)(tid >> 3) * T_ + (tid & 7) * 8);
    {
        const int tk = tid >> 4, tq = t0 + tk, cur = tq >> 6;
#pragma unroll
        for (int e = 0; e < 4; ++e) { const int jb = (tid & 15) + 16 * e; const LAS float* pr = PS + tk * 256 + 4 * jb;
            float v = pr[0] + pr[1] + pr[2] + 0.5f * pr[3] + (jb > 0 ? 0.5f * pr[-1] : 0.f);
            const bool forced = (jb == 0) || (jb == cur) || (jb == cur - 1);
            v = (jb <= cur) ? (forced ? v + 1000.f : v) : -1.f;
            IMP[tk * 64 + jb] = v; }
    }
    __syncthreads();
    {
        const float v0 = IMP[(4 * wid + 0) * 64 + lane], v1 = IMP[(4 * wid + 1) * 64 + lane], v2 = IMP[(4 * wid + 2) * 64 + lane], v3 = IMP[(4 * wid + 3) * 64 + lane];
        int r0 = 0, r1 = 0, r2 = 0, r3 = 0;
#pragma unroll
        for (int j = 0; j < 64; ++j) { const float s0 = RDLANE(v0, j), s1 = RDLANE(v1, j), s2 = RDLANE(v2, j), s3 = RDLANE(v3, j); const bool lo = j < lane;
            r0 += (s0 > v0 || (s0 == v0 && lo)) ? 1 : 0; r1 += (s1 > v1 || (s1 == v1 && lo)) ? 1 : 0; r2 += (s2 > v2 || (s2 == v2 && lo)) ? 1 : 0; r3 += (s3 > v3 || (s3 == v3 && lo)) ? 1 : 0; }
        const u64 m0 = __ballot(r0 < 16), m1 = __ballot(r1 < 16), m2 = __ballot(r2 < 16), m3 = __ballot(r3 < 16);
        if (lane == 0) { MASK[4 * wid + 0] = m0; MASK[4 * wid + 1] = m1; MASK[4 * wid + 2] = m2; MASK[4 * wid + 3] = m3; }
    }
    __syncthreads();
    const u64 mymask = MASK[4 * wid + tl];
    u64 uni = MASK[lane & 31];
#pragma unroll
    for (int o = 16; o >= 1; o >>= 1) uni |= __shfl_xor(uni, o);
    const int cur = t0 >> 6;
    uni &= (cur == 63) ? ~0ull : ((2ull << cur) - 1ull);
    uni = ((u64)(unsigned)__builtin_amdgcn_readfirstlane((unsigned)(uni >> 32)) << 32) | (u64)(unsigned)__builtin_amdgcn_readfirstlane((unsigned)uni);
    const bf16_t* VTg = (const bf16_t*)(ws + WS_VT);
#pragma unroll 1
    for (int br = 1; br <= 2; ++br) {
        const bf16_t* Kg = HB + (size_t)((br == 1 ? 12 : 14) + g) * 16 * SQ * 64 + (size_t)b * SQ * 64;
        const bf16_t* Vg = VTg + (size_t)((br == 1 ? 0 : 2) + g) * 64 * T_ + (size_t)b * SQ;
        u64 list;
        if (br == 1) list = uni;
        else { const int lo = (t0 >= 511 ? (t0 - 511) >> 6 : 0), hi = t0 >> 6; list = ((hi == 63) ? ~0ull : ((2ull << hi) - 1ull)) & ~((1ull << lo) - 1ull); }
        float mrun = -1e30f, lrun = 0.f; f32x4 o[4];
#pragma unroll
        for (int dt = 0; dt < 4; ++dt) o[dt] = (f32x4){0.f, 0.f, 0.f, 0.f};
        const int lr = tid >> 3, lch = tid & 7;
        int j = __builtin_ctzll(list); list &= list - 1;
        { u32x4 kv = kv_first, vv = vv_first;
          if (br != 1) { kv = *(const u32x4*)(Kg + (size_t)(64 * j + lr) * 64 + lch * 8); vv = *(const u32x4*)(Vg + (size_t)lr * T_ + 64 * j + lch * 8); }
          *(LAS u32x4*)(Kc + lr * 72 + 32 * (lr >> 4) + lch * 8) = kv; *(LAS u32x4*)(Vc + lr * 72 + lch * 8) = vv; }
        __syncthreads();
        int buf = 0;
        for (;;) {
            const int jn = list ? __builtin_ctzll(list) : -1; list &= list - 1;
            u32x4 kv, vv;
            if (jn >= 0) { kv = *(const u32x4*)(Kg + (size_t)(64 * jn + lr) * 64 + lch * 8); vv = *(const u32x4*)(Vg + (size_t)lr * T_ + 64 * jn + lch * 8); }
            unsigned vm = 0u;
            if (br == 1) { if ((mymask >> j) & 1ull) { if (j < cur) vm = 0xffffu; else {
#pragma unroll
                        for (int ti = 0; ti < 4; ++ti)
#pragma unroll
                            for (int jj = 0; jj < 4; ++jj) { const int key = 64 * j + 32 * (ti >> 1) + 8 * q4 + 4 * (ti & 1) + jj; if (key <= t) vm |= 1u << (ti * 4 + jj); } } } }
            else {
                const int tw0 = t0 + 4 * wid;
                if (64 * j + 63 <= tw0 && 64 * j > tw0 + 3 - 512) vm = 0xffffu;
                else {
#pragma unroll
                    for (int ti = 0; ti < 4; ++ti)
#pragma unroll
                        for (int jj = 0; jj < 4; ++jj) { const int key = 64 * j + 32 * (ti >> 1) + 8 * q4 + 4 * (ti & 1) + jj; if (key <= t && key > t - 512) vm |= 1u << (ti * 4 + jj); } } }
            if (__any(vm != 0u)) { f32x4 st[4];
                if (!__any(vm != 0u && vm != 0xffffu)) { qk_tile_bias<64, 72>(Kc + buf * KT72, qf, st, vm ? 0.f : -INFINITY, lane); softmax_pv_fast<64, 72>(st, mrun, lrun, o, Vc + buf * 4608, lane); }
                else { qk_tile<64, 72>(Kc + buf * KT72, qf, st, lane); softmax_pv<64, 72>(st, vm, mrun, lrun, o, Vc + buf * 4608, lane); } }
            if (jn >= 0) { *(LAS u32x4*)(Kc + (buf ^ 1) * KT72 + lr * 72 + 32 * (lr >> 4) + lch * 8) = kv; *(LAS u32x4*)(Vc + (buf ^ 1) * 4608 + lr * 72 + lch * 8) = vv; }
            __syncthreads();
            if (jn < 0) break;
            j = jn; buf ^= 1;
        }
        float lt = lrun; lt += __shfl_xor(lt, 16); lt += __shfl_xor(lt, 32);
        const float sc_ = (br == 1 ? gate1 : gate2) * (lt > 0.f ? __builtin_amdgcn_rcpf(lt) : 0.f);
#pragma unroll
        for (int dt = 0; dt < 4; ++dt) outacc[dt] += o[dt] * sc_;
    }
    { bf16_t* dst = (bf16_t*)(ws + WS_ACT) + (size_t)tok * 1024 + h * 64 + 4 * q4;
#pragma unroll
      for (int dt = 0; dt < 4; ++dt) { u32x2 w; w.x = cvt_pk_bf16(outacc[dt][0], outacc[dt][1]); w.y = cvt_pk_bf16(outacc[dt][2], outacc[dt][3]); *(u32x2*)(dst + 16 * dt) = w; } }
}

__device__ void xattn_block(const Params& p, unsigned char* ldsg, int blk, int layer) {
    LAS unsigned char* lds = (LAS unsigned char*)ldsg;
    const int tid = opaque_tid(), lane = tid & 63, wid = __builtin_amdgcn_readfirstlane(tid >> 6), c = lane & 15, q4 = lane >> 4;
    const int qq = blk & 3, h = (blk >> 2) & 3, b = blk >> 4;
    unsigned char* ws = p.ws;
    const bf16_t* QX = (const bf16_t*)(ws + WS_QX); const bf16_t* KM = (const bf16_t*)(ws + WS_KMEM) + (size_t)layer * 4096 * 512; const bf16_t* VM = (const bf16_t*)(ws + WS_VMT) + (size_t)layer * 512 * 4096;
    LAS bf16_t* Kb = (LAS bf16_t*)lds;
    LAS bf16_t* Vb = (LAS bf16_t*)(lds + 4 * KT136 * 2);
    __syncthreads();
#pragma unroll
    for (int i = 0; i < 8; ++i) { const int e = tid + 512 * i; const int row = e >> 4, rl = row & 63; *(LAS u32x4*)(Kb + (row >> 6) * KT136 + rl * 136 + 32 * (rl >> 4) + (e & 15) * 8) = *(const u32x4*)(KM + (size_t)(b * 256 + row) * 512 + h * 128 + (e & 15) * 8); }
#pragma unroll
    for (int i = 0; i < 8; ++i) { const int e = tid + 512 * i; *(LAS u32x4*)(Vb + (e >> 5) * 264 + (e & 31) * 8) = *(const u32x4*)(VM + (size_t)(h * 128 + (e >> 5)) * 4096 + b * 256 + (e & 31) * 8); }
    __syncthreads();
    bf16x8 qn[4];
#pragma unroll
    for (int kc = 0; kc < 4; ++kc) qn[kc] = *(const bf16x8*)(QX + (size_t)(b * SQ + (qq * 8) * 128 + wid * 16 + c) * 512 + h * 128 + 32 * kc + 8 * q4);
#pragma unroll 1
    for (int qt = 0; qt < 8; ++qt) {
        const int tok = b * SQ + (qq * 8 + qt) * 128 + wid * 16 + c;
        bf16x8 qf[4];
#pragma unroll
        for (int kc = 0; kc < 4; ++kc) qf[kc] = qn[kc];
        if (qt < 7) {
#pragma unroll
            for (int kc = 0; kc < 4; ++kc) qn[kc] = *(const bf16x8*)(QX + (size_t)(tok + 128) * 512 + h * 128 + 32 * kc + 8 * q4); }
        float mrun = -1e30f, lrun = 0.f; f32x4 o[8];
#pragma unroll
        for (int dt = 0; dt < 8; ++dt) o[dt] = (f32x4){0.f, 0.f, 0.f, 0.f};
#pragma unroll 1
        for (int j = 0; j < 4; ++j) { f32x4 st[4]; qk_tile<128, 136>(Kb + j * KT136, qf, st, lane); softmax_pv_fast<128, 264>(st, mrun, lrun, o, Vb + 64 * j, lane); }
        float lt = lrun; lt += __shfl_xor(lt, 16); lt += __shfl_xor(lt, 32);
        const float inv = __builtin_amdgcn_rcpf(lt);
        bf16_t* dst = (bf16_t*)(ws + WS_OX) + (size_t)tok * 512 + h * 128 + 4 * q4;
#pragma unroll
        for (int dt = 0; dt < 8; ++dt) { u32x2 w; w.x = cvt_pk_bf16(o[dt][0] * inv, o[dt][1] * inv); w.y = cvt_pk_bf16(o[dt][2] * inv, o[dt][3] * inv); *(u32x2*)(dst + 16 * dt) = w; }
    }
}

__device__ void gdn_g1(const Params& p, int gw, int nw, int lane) {
    unsigned char* ws = p.ws;
    const bf16_t* __restrict__ HB = (const bf16_t*)(ws + WS_HB); const float* __restrict__ SM = (const float*)(ws + WS_SM); const float* __restrict__ cw = p.in[13];
    bf16_t* __restrict__ QN = (bf16_t*)(ws + WS_QN); bf16_t* __restrict__ KN = (bf16_t*)(ws + WS_KN); bf16_t* __restrict__ VB = (bf16_t*)(ws + WS_VB);
    const int tl = lane >> 4, dq = (lane & 15) * 4;
    for (int cid = gw; cid < 8192; cid += nw) {
        const int bh = cid >> 6, cc = cid & 63, h = bh >> 4, b = bh & 15, s0 = cc * 64;
        const bf16_t* xs[3] = { HB + ((size_t)((16 + h) * 16 + b) * SQ) * 64 + dq, HB + ((size_t)((24 + h) * 16 + b) * SQ) * 64 + dq, HB + ((size_t)((32 + h) * 16 + b) * SQ) * 64 + dq };
        f32x4 wt[3][4];
#pragma unroll
        for (int x = 0; x < 3; ++x)
#pragma unroll
            for (int j = 0; j < 4; ++j) wt[x][j] = *(const f32x4*)(cw + j * 1536 + x * 512 + h * 64 + dq);
#pragma unroll 4
        for (int it = 0; it < 16; ++it) {
            const int s = s0 + 4 * it + tl;
            f32x4 y[3];
#pragma unroll
            for (int x = 0; x < 3; ++x) {
                f32x4 acc = (f32x4){0.f, 0.f, 0.f, 0.f};
#pragma unroll
                for (int j = 0; j < 4; ++j) { const int sj = s - 3 + j; u32x2 raw = (u32x2){0u, 0u}; if (sj >= 0) raw = *(const u32x2*)(xs[x] + (size_t)sj * 64);
                    const f32x4 xv = (f32x4){bf2f((bf16_t)(raw.x & 0xffff)), bf2f((bf16_t)(raw.x >> 16)), bf2f((bf16_t)(raw.y & 0xffff)), bf2f((bf16_t)(raw.y >> 16))};
                    acc += wt[x][j] * xv; }
#pragma unroll
                for (int e = 0; e < 4; ++e) acc[e] = siluf_(acc[e]);
                y[x] = acc;
            }
            float sq = y[0][0] * y[0][0] + y[0][1] * y[0][1] + y[0][2] * y[0][2] + y[0][3] * y[0][3], sk = y[1][0] * y[1][0] + y[1][1] * y[1][1] + y[1][2] * y[1][2] + y[1][3] * y[1][3];
#pragma unroll
            for (int o = 1; o < 16; o <<= 1) { sq += __shfl_xor(sq, o); sk += __shfl_xor(sk, o); }
            const float rq = rsqrtf(sq + 1e-6f) * 0.125f, rk = rsqrtf(sk + 1e-6f);
            const float beta = sigmoidf_(SM[(size_t)(b * SQ + s) * 64 + 32 + h]);
            const size_t o = (size_t)cid * 4096 + (4 * it + tl) * 64 + dq;
            u32x2 w; w.x = cvt_pk_bf16(y[0][0] * rq, y[0][1] * rq); w.y = cvt_pk_bf16(y[0][2] * rq, y[0][3] * rq); *(u32x2*)(QN + o) = w;
            w.x = cvt_pk_bf16(y[1][0] * rk, y[1][1] * rk); w.y = cvt_pk_bf16(y[1][2] * rk, y[1][3] * rk); *(u32x2*)(KN + o) = w;
            w.x = cvt_pk_bf16(y[2][0] * beta, y[2][1] * beta); w.y = cvt_pk_bf16(y[2][2] * beta, y[2][3] * beta); *(u32x2*)(VB + o) = w;
        }
    }
}
__device__ void gdn_g2(const Params& p, LAS float* Aw, int cid, int lane) {
    unsigned char* ws = p.ws;
    const float* SM = (const float*)(ws + WS_SM);
    bf16_t* QN = (bf16_t*)(ws + WS_QN) + (size_t)cid * 4096; bf16_t* KN = (bf16_t*)(ws + WS_KN) + (size_t)cid * 4096; bf16_t* VB = (bf16_t*)(ws + WS_VB) + (size_t)cid * 4096;
    bf16_t* QKM = (bf16_t*)(ws + WS_QKM) + (size_t)cid * 4096; bf16_t* KDT = (bf16_t*)(ws + WS_KDT) + (size_t)cid * 4096;
    const int r = lane & 15, q4 = lane >> 4;
    const int bh = cid >> 6, cc = cid & 63, h = bh >> 4, b = bh & 15, tok0 = b * SQ + cc * 64;
    float gcs; { const float xx = SM[(size_t)(tok0 + lane) * 64 + 24 + h] + p.in[15][h]; const float sp = xx > 20.f ? xx : log1pf(__expf(xx)); gcs = -__expf(p.in[14][h]) * sp; }
    const float beta = sigmoidf_(SM[(size_t)(tok0 + lane) * 64 + 32 + h]);
#pragma unroll
    for (int o = 1; o < 64; o <<= 1) { const float v = __shfl_up(gcs, o); if (lane >= o) gcs += v; }
    const float gl = __shfl(gcs, 63);
    if (lane == 0) ((float*)(ws + WS_EGL))[cid] = __expf(gl);
    const float wcoef = beta * __expf(gcs), kdcoef = __expf(gl - gcs), qcoef = __expf(gcs);
    {
        bf16x8 kcol[4][2];
#pragma unroll
        for (int ct = 0; ct < 4; ++ct)
#pragma unroll
            for (int kc = 0; kc < 2; ++kc) kcol[ct][kc] = *(const bf16x8*)(KN + (16 * ct + r) * 64 + 32 * kc + 8 * q4);
        float gj[4];
#pragma unroll
        for (int ct = 0; ct < 4; ++ct) gj[ct] = __shfl(gcs, 16 * ct + r);
#pragma unroll 1
        for (int rt = 0; rt < 4; ++rt) {
            bf16x8 krow[2], qrow[2];
#pragma unroll
            for (int kc = 0; kc < 2; ++kc) { krow[kc] = *(const bf16x8*)(KN + (16 * rt + r) * 64 + 32 * kc + 8 * q4); qrow[kc] = *(const bf16x8*)(QN + (16 * rt + r) * 64 + 32 * kc + 8 * q4); }
            float gi[4], bi[4];
#pragma unroll
            for (int jj = 0; jj < 4; ++jj) { gi[jj] = __shfl(gcs, 16 * rt + 4 * q4 + jj); bi[jj] = __shfl(beta, 16 * rt + 4 * q4 + jj); }
#pragma unroll
            for (int ct = 0; ct < 4; ++ct) {
                f32x4 a = (f32x4){0.f, 0.f, 0.f, 0.f}, qa = (f32x4){0.f, 0.f, 0.f, 0.f};
                if (ct <= rt) { a = MFMA16(krow[0], kcol[ct][0], a); a = MFMA16(krow[1], kcol[ct][1], a); qa = MFMA16(qrow[0], kcol[ct][0], qa); qa = MFMA16(qrow[1], kcol[ct][1], qa); }
#pragma unroll
                for (int jj = 0; jj < 4; ++jj) { const int i = 16 * rt + 4 * q4 + jj, j = 16 * ct + r;
                    const float dec = (j <= i) ? __expf(gi[jj] - gj[ct]) : 0.f;
                    Aw[i * 64 + j] = (j < i) ? a[jj] * bi[jj] * dec : 0.f;
                    QKM[i * 64 + j] = f2bf(qa[jj] * dec); }
            }
        }
    }
    asm volatile("s_waitcnt lgkmcnt(0)" ::: "memory");
    __builtin_amdgcn_wave_barrier();
    float arow[64];
#pragma unroll
    for (int j4 = 0; j4 < 16; ++j4) { const f32x4 a4 = *(const LAS f32x4*)(Aw + lane * 64 + 4 * j4); arow[4 * j4] = a4[0]; arow[4 * j4 + 1] = a4[1]; arow[4 * j4 + 2] = a4[2]; arow[4 * j4 + 3] = a4[3]; }
    asm volatile("s_waitcnt lgkmcnt(0)" ::: "memory");
    __builtin_amdgcn_wave_barrier();
    typedef float f32x2_ __attribute__((ext_vector_type(2)));
    const int crow = lane >> 3, ccol = (lane & 7) * 8;
#define G2_LOADPUT(SRC) do { u32x4 tch[8]; _Pragma("unroll") for (int k = 0; k < 8; ++k) tch[k] = *(const u32x4*)((SRC) + (crow + 8 * k) * 64 + ccol); \
        _Pragma("unroll") for (int k = 0; k < 8; ++k) { const unsigned w_[4] = {tch[k].x, tch[k].y, tch[k].z, tch[k].w}; \
            _Pragma("unroll") for (int e = 0; e < 8; ++e) Aw[(crow + 8 * k) * 65 + ccol + e] = (e & 1) ? __uint_as_float(w_[e >> 1] & 0xffff0000u) : __uint_as_float(w_[e >> 1] << 16); \
            asm volatile("" ::: "memory"); } } while (0)
#define G2_SOLVE(rowc) do { _Pragma("unroll 1") for (int c0 = 0; c0 < 64; c0 += 4) { \
            f32x2_ xa = (f32x2_){Aw[lane * 65 + c0] * (rowc), Aw[lane * 65 + c0 + 1] * (rowc)}, xb = (f32x2_){Aw[lane * 65 + c0 + 2] * (rowc), Aw[lane * 65 + c0 + 3] * (rowc)}; \
            _Pragma("unroll") for (int j = 0; j < 63; ++j) { const f32x2_ sa = (f32x2_){RDLANE(xa.x, j), RDLANE(xa.y, j)}, sb = (f32x2_){RDLANE(xb.x, j), RDLANE(xb.y, j)}; \
                const f32x2_ aj = (f32x2_){arow[j], arow[j]}; xa = __builtin_elementwise_fma(-aj, sa, xa); xb = __builtin_elementwise_fma(-aj, sb, xb); } \
            Aw[lane * 65 + c0] = xa.x; Aw[lane * 65 + c0 + 1] = xa.y; Aw[lane * 65 + c0 + 2] = xb.x; Aw[lane * 65 + c0 + 3] = xb.y; } } while (0)
#define G2_GET(DST) do { _Pragma("unroll") for (int k = 0; k < 8; ++k) { const LAS float* t_ = Aw + (crow + 8 * k) * 65 + ccol; u32x4 w_; \
            w_.x = cvt_pk_bf16(t_[0], t_[1]); w_.y = cvt_pk_bf16(t_[2], t_[3]); w_.z = cvt_pk_bf16(t_[4], t_[5]); w_.w = cvt_pk_bf16(t_[6], t_[7]); *(u32x4*)((DST) + (crow + 8 * k) * 64 + ccol) = w_; \
            if (k & 1) asm volatile("" ::: "memory"); } } while (0)
#define G2_SYNC() do { asm volatile("s_waitcnt lgkmcnt(0)" ::: "memory"); __builtin_amdgcn_wave_barrier(); } while (0)
#pragma unroll 1
    for (int pass = 0; pass < 2; ++pass) {
        bf16_t* RX = pass == 0 ? VB : KN;
        G2_LOADPUT(RX);
        G2_SYNC();
        if (pass == 1) {
#pragma unroll 2
            for (int i8 = 0; i8 < 8; ++i8) { unsigned kd[4];
#pragma unroll
                for (int e = 0; e < 8; ++e) { const int i = 8 * i8 + e; const unsigned v = (unsigned)f2bf(Aw[i * 65 + lane] * RDLANE(kdcoef, i));
                    if (e & 1) kd[e >> 1] |= v << 16; else kd[e >> 1] = v; }
                u32x4 w; w.x = kd[0]; w.y = kd[1]; w.z = kd[2]; w.w = kd[3]; *(u32x4*)(KDT + lane * 64 + 8 * i8) = w; }
            G2_SYNC();
        }
        const float rowc = pass == 0 ? 1.f : wcoef;
        G2_SOLVE(rowc);
        G2_SYNC();
        G2_GET(RX);
        G2_SYNC();
    }
    { u32x4 tch[8];
#pragma unroll
      for (int k = 0; k < 8; ++k) tch[k] = *(const u32x4*)(QN + (crow + 8 * k) * 64 + ccol);
#pragma unroll
      for (int k = 0; k < 8; ++k) { const float qc = __shfl(qcoef, crow + 8 * k); const unsigned w_[4] = {tch[k].x, tch[k].y, tch[k].z, tch[k].w}; u32x4 o_;
        o_.x = cvt_pk_bf16(__uint_as_float(w_[0] << 16) * qc, __uint_as_float(w_[0] & 0xffff0000u) * qc); o_.y = cvt_pk_bf16(__uint_as_float(w_[1] << 16) * qc, __uint_as_float(w_[1] & 0xffff0000u) * qc);
        o_.z = cvt_pk_bf16(__uint_as_float(w_[2] << 16) * qc, __uint_as_float(w_[2] & 0xffff0000u) * qc); o_.w = cvt_pk_bf16(__uint_as_float(w_[3] << 16) * qc, __uint_as_float(w_[3] & 0xffff0000u) * qc);
        *(u32x4*)(QN + (crow + 8 * k) * 64 + ccol) = o_; } }
    G2_SYNC();
#undef G2_LOADPUT
#undef G2_SOLVE
#undef G2_GET
#undef G2_SYNC
}
constexpr int GC_OB = 0, GC_OP = 34816, GC_OPSZ = 46080, GC_TILE = 9216;
__device__ void gdn_chain(const Params& p, unsigned char* ldsg, int bh) {
    unsigned char* ws = p.ws;
    LAS unsigned char* lds = (LAS unsigned char*)ldsg;
    const int tid = opaque_tid(), lane = tid & 63, wid = __builtin_amdgcn_readfirstlane(tid >> 6), r = lane & 15, q4 = lane >> 4, ct = wid & 3;
    const int h = bh >> 4, b = bh & 15;
    const bf16_t* __restrict__ HB = (const bf16_t*)(ws + WS_HB); const float* __restrict__ gnw = p.in[16];
    LAS float* obuf = (LAS float*)(lds + GC_OB);
    f32x4 S[4];
#pragma unroll
    for (int rt = 0; rt < 4; ++rt) S[rt] = (f32x4){0.f, 0.f, 0.f, 0.f};
    const bf16_t* __restrict__ zb = HB + ((size_t)((40 + h) * 16 + b) * SQ) * 64;
    bf16_t* __restrict__ mix = (bf16_t*)(ws + WS_ACT) + (size_t)b * SQ * 1024 + 512 + h * 64;
    const float* __restrict__ EGLb = (const float*)(ws + WS_EGL) + bh * 64;
    const int ltid = tid - 256;
    u32x4 lr[10];
#define GC_LOAD(n) do { _Pragma("unroll") for (int i = 0; i < 10; ++i) { const int e = ltid + 256 * i, tile = i >> 1  , row = (e >> 3) & 63, ch = e & 7; \
        const size_t toff = tile == 0 ? WS_KN : tile == 1 ? WS_QN : tile == 2 ? WS_QKM : tile == 3 ? WS_KDT : WS_VB; \
        lr[i] = *(const u32x4*)((const bf16_t*)(ws + toff) + ((size_t)bh * 64 + (n)) * 4096 + row * 64 + ch * 8); } } while (0)
#define GC_STORE(n) do { _Pragma("unroll") for (int i = 0; i < 10; ++i) { const int e = ltid + 256 * i, tile = i >> 1, row = (e >> 3) & 63, ch = e & 7; \
        *(LAS u32x4*)(lds + GC_OP + ((n) & 1) * GC_OPSZ + tile * GC_TILE + row * 144 + ch * 16) = lr[i]; } } while (0)
#define LDP(tile, row, kc) __builtin_bit_cast(bf16x8, (u32x4){ ((const LAS u32x2*)(opb + (tile) * GC_TILE + (row) * 144 + (32 * (kc) + 4 * q4) * 2))[0].x, ((const LAS u32x2*)(opb + (tile) * GC_TILE + (row) * 144 + (32 * (kc) + 4 * q4) * 2))[0].y, \
                                                        ((const LAS u32x2*)(opb + (tile) * GC_TILE + (row) * 144 + (32 * (kc) + 16 + 4 * q4) * 2))[0].x, ((const LAS u32x2*)(opb + (tile) * GC_TILE + (row) * 144 + (32 * (kc) + 16 + 4 * q4) * 2))[0].y })
    __syncthreads();
    float egl = 0.f;
    if (wid >= 4) { GC_LOAD(0); GC_STORE(0); GC_LOAD(1); } else egl = EGLb[0];
    __syncthreads();
#pragma unroll 1
    for (int cc = 0; cc <= 64; ++cc) {
        if (wid < 4) {
            if (cc < 64) {
                LAS float* ob = obuf + (cc & 1) * 64 * 68;
                const LAS unsigned char* opb = lds + GC_OP + (cc & 1) * GC_OPSZ;
                const float egl_c = egl; if (cc < 63) egl = EGLb[cc + 1];
                bf16x8 sb[2], vb[2];
#pragma unroll
                for (int kc = 0; kc < 2; ++kc) { u32x4 pk; pk.x = cvt_pk_bf16(S[2 * kc][0], S[2 * kc][1]); pk.y = cvt_pk_bf16(S[2 * kc][2], S[2 * kc][3]); pk.z = cvt_pk_bf16(S[2 * kc + 1][0], S[2 * kc + 1][1]); pk.w = cvt_pk_bf16(S[2 * kc + 1][2], S[2 * kc + 1][3]); sb[kc] = __builtin_bit_cast(bf16x8, pk); }
                f32x4 vn[4];
#pragma unroll
                for (int rt = 0; rt < 4; ++rt) {
                    f32x4 a = (f32x4){0.f, 0.f, 0.f, 0.f};
                    a = MFMA16(LDP(0, 16 * rt + r, 0), sb[0], a); a = MFMA16(LDP(0, 16 * rt + r, 1), sb[1], a);
#pragma unroll
                    for (int jj = 0; jj < 4; ++jj) vn[rt][jj] = bf2f(*(const LAS bf16_t*)(opb + 4 * GC_TILE + (16 * rt + 4 * q4 + jj) * 144 + (16 * ct + r) * 2)) - a[jj];
                }
#pragma unroll
                for (int kc = 0; kc < 2; ++kc) { u32x4 pk; pk.x = cvt_pk_bf16(vn[2 * kc][0], vn[2 * kc][1]); pk.y = cvt_pk_bf16(vn[2 * kc][2], vn[2 * kc][3]); pk.z = cvt_pk_bf16(vn[2 * kc + 1][0], vn[2 * kc + 1][1]); pk.w = cvt_pk_bf16(vn[2 * kc + 1][2], vn[2 * kc + 1][3]); vb[kc] = __builtin_bit_cast(bf16x8, pk); }
#pragma unroll
                for (int rt = 0; rt < 4; ++rt) {
                    f32x4 a = (f32x4){0.f, 0.f, 0.f, 0.f};
                    a = MFMA16(LDP(1, 16 * rt + r, 0), sb[0], a); a = MFMA16(LDP(1, 16 * rt + r, 1), sb[1], a);
                    a = MFMA16(LDP(2, 16 * rt + r, 0), vb[0], a); a = MFMA16(LDP(2, 16 * rt + r, 1), vb[1], a);
#pragma unroll
                    for (int jj = 0; jj < 4; ++jj) ob[(16 * rt + 4 * q4 + jj) * 68 + 16 * ct + r] = a[jj];
                }
#pragma unroll
                for (int rt = 0; rt < 4; ++rt) {
                    f32x4 a = S[rt] * egl_c;
                    a = MFMA16(LDP(3, 16 * rt + r, 0), vb[0], a); a = MFMA16(LDP(3, 16 * rt + r, 1), vb[1], a);
                    S[rt] = a;
                }
            }
        } else {
            if (cc + 1 < 64) GC_STORE(cc + 1);
            if (cc + 2 < 64) GC_LOAD(cc + 2);
            if (cc >= 1) {
                const LAS float* ob = obuf + ((cc - 1) & 1) * 64 * 68;
                const int row = 16 * (wid - 4) + (lane >> 2), qd = lane & 3, s = (cc - 1) * 64 + row;
                const u32x4 z0 = *(const u32x4*)(zb + (size_t)s * 64 + 16 * qd), z1 = *(const u32x4*)(zb + (size_t)s * 64 + 16 * qd + 8);
                f32x4 v[4]; float ss = 0.f;
#pragma unroll
                for (int i = 0; i < 4; ++i) { v[i] = *(const LAS f32x4*)(ob + row * 68 + 16 * qd + 4 * i); ss += v[i][0] * v[i][0] + v[i][1] * v[i][1] + v[i][2] * v[i][2] + v[i][3] * v[i][3]; }
                ss += __shfl_xor(ss, 1); ss += __shfl_xor(ss, 2);
                const float rstd = rsqrtf(ss * (1.f / 64.f) + 1e-6f);
                const unsigned zw[8] = {z0.x, z0.y, z0.z, z0.w, z1.x, z1.y, z1.z, z1.w};
                unsigned ow[8];
#pragma unroll
                for (int i = 0; i < 8; ++i) { const float za = bf2f((bf16_t)(zw[i] & 0xffff)), zc = bf2f((bf16_t)(zw[i] >> 16));
                    const float a = v[i >> 1][(i & 1) * 2] * rstd * gnw[16 * qd + 2 * i] * siluf_(za), c = v[i >> 1][(i & 1) * 2 + 1] * rstd * gnw[16 * qd + 2 * i + 1] * siluf_(zc);
                    ow[i] = cvt_pk_bf16(a, c); }
                u32x4 w0, w1; w0.x = ow[0]; w0.y = ow[1]; w0.z = ow[2]; w0.w = ow[3]; w1.x = ow[4]; w1.y = ow[5]; w1.z = ow[6]; w1.w = ow[7];
                *(u32x4*)(mix + (size_t)s * 1024 + 16 * qd) = w0; *(u32x4*)(mix + (size_t)s * 1024 + 16 * qd + 8) = w1;
            }
        }
        __syncthreads();
    }
#undef LDP
#undef GC_LOAD
#undef GC_STORE
}
__device__ void cmp_stage2(const Params& p, unsigned char* ldsg) {
    unsigned char* ws = p.ws;
    const int tid = opaque_tid(), lane = tid & 63, wid = __builtin_amdgcn_readfirstlane(tid >> 6), G = gridDim.x;
    float* w2s = (float*)ldsg;
    for (int e = tid; e < 2 * 128 * 64; e += 512) w2s[e] = (e < 8192) ? p.in[9][e] : p.in[12][e - 8192];
    __syncthreads();
    const bf16_t* HID = (const bf16_t*)(ws + WS_HID); bf16_t* KC = (bf16_t*)(ws + WS_KC); bf16_t* VCT = (bf16_t*)(ws + WS_VCT);
    for (int r8 = blockIdx.x * 8 + wid; r8 < 2048; r8 += G * 8) {
        const int row0 = r8 * 8, isv = row0 >> 13, hb = (row0 >> 8) & 31, n0 = row0 & 255;
        const float* w = w2s + isv * 8192;
        float acc[8]; float h0[8], h1[8];
#pragma unroll
        for (int k = 0; k < 8; ++k) { const bf16_t* hr = HID + (size_t)(row0 + k) * 128; h0[k] = bf2f(hr[lane]); h1[k] = bf2f(hr[64 + lane]); acc[k] = 0.f; }
#pragma unroll 4
        for (int cc = 0; cc < 64; ++cc) { const float wa = w[cc * 64 + lane], wb = w[(64 + cc) * 64 + lane];
#pragma unroll
            for (int k = 0; k < 8; ++k) acc[k] += RDLANE(h0[k], cc) * wa + RDLANE(h1[k], cc) * wb; }
        if (n0 == 248) acc[7] = 0.f;
        if (!isv) {
#pragma unroll
            for (int k = 0; k < 8; ++k) KC[((size_t)hb * 256 + n0 + k) * 64 + lane] = f2bf(acc[k]);
        } else { u32x4 wv; wv.x = cvt_pk_bf16(acc[0], acc[1]); wv.y = cvt_pk_bf16(acc[2], acc[3]); wv.z = cvt_pk_bf16(acc[4], acc[5]); wv.w = cvt_pk_bf16(acc[6], acc[7]);
            *(u32x4*)(VCT + ((size_t)hb * 64 + lane) * 256 + n0) = wv; }
    }
    __syncthreads();
}
__device__ void sc_conv(const Params& p) {
    unsigned char* ws = p.ws;
    const bf16_t* __restrict__ SC = (const bf16_t*)(ws + WS_SC); bf16_t* __restrict__ Y = (bf16_t*)(ws + WS_ACT); const float* __restrict__ cw = p.in[19];
#pragma unroll 4
    for (size_t e = (size_t)blockIdx.x * 512 + opaque_tid(); e < (size_t)T_ * 128; e += (size_t)gridDim.x * 512) {
        const int t = (int)(e >> 7), c8 = (int)(e & 127) * 8, s = t & 4095;
        float acc[8];
#pragma unroll
        for (int i = 0; i < 8; ++i) acc[i] = 0.f;
#pragma unroll
        for (int j = 0; j < 3; ++j) { const int d = 2 - j; if (s - d >= 0) {
                const u32x4 cg = *(const u32x4*)(SC + (size_t)(t - d) * 3072 + 1024 + c8), uu = *(const u32x4*)(SC + (size_t)(t - d) * 3072 + 2048 + c8);
                const unsigned cgw[4] = {cg.x, cg.y, cg.z, cg.w}, uw[4] = {uu.x, uu.y, uu.z, uu.w};
#pragma unroll
                for (int i = 0; i < 8; ++i) { const float cv = bf2f((bf16_t)((cgw[i >> 1] >> ((i & 1) * 16)) & 0xffff)), uv = bf2f((bf16_t)((uw[i >> 1] >> ((i & 1) * 16)) & 0xffff)); acc[i] += cw[j * 1024 + c8 + i] * bf2f(f2bf(cv * uv)); } } }
        const u32x4 bg = *(const u32x4*)(SC + (size_t)t * 3072 + c8); const unsigned bw[4] = {bg.x, bg.y, bg.z, bg.w};
        u32x4 w; unsigned ow[4];
#pragma unroll
        for (int i = 0; i < 4; ++i) { const float b0 = bf2f((bf16_t)(bw[i] & 0xffff)), b1 = bf2f((bf16_t)(bw[i] >> 16)); ow[i] = cvt_pk_bf16(b0 * acc[2 * i], b1 * acc[2 * i + 1]); }
        w.x = ow[0]; w.y = ow[1]; w.z = ow[2]; w.w = ow[3];
        *(u32x4*)(Y + (size_t)t * 1024 + c8) = w;
    }
}
__device__ void final_norm(const Params& p) {
    const int lane = opaque_tid() & 63, gw = blockIdx.x * 8 + __builtin_amdgcn_readfirstlane(opaque_tid() >> 6), nw = gridDim.x * 8; const float* w = p.in[27];
    const float* ssq = (const float*)(p.ws + WS_SSQ) + (size_t)5 * T_; const bf16_t* __restrict__ XS = (const bf16_t*)(p.ws + WS_ACT2);
    f32x4 wv[4];
#pragma unroll
    for (int i = 0; i < 4; ++i) wv[i] = *(const f32x4*)(w + i * 256 + lane * 4);
    for (int r = gw; r < T_; r += 2 * nw) {
        const int r2 = r + nw;
        const float ra = rsqrtf(ssq[r] * (1.f / 1024.f) + 1e-6f), rb = rsqrtf(ssq[r2] * (1.f / 1024.f) + 1e-6f);
        u32x2 va[4], vb[4];
#pragma unroll
        for (int i = 0; i < 4; ++i) { va[i] = *(const u32x2*)(XS + (size_t)r * 1024 + i * 256 + lane * 4); vb[i] = *(const u32x2*)(XS + (size_t)r2 * 1024 + i * 256 + lane * 4); }
#pragma unroll
        for (int i = 0; i < 4; ++i) {
            const f32x4 xa = (f32x4){__uint_as_float(va[i].x << 16), __uint_as_float(va[i].x & 0xffff0000u), __uint_as_float(va[i].y << 16), __uint_as_float(va[i].y & 0xffff0000u)};
            const f32x4 xb = (f32x4){__uint_as_float(vb[i].x << 16), __uint_as_float(vb[i].x & 0xffff0000u), __uint_as_float(vb[i].y << 16), __uint_as_float(vb[i].y & 0xffff0000u)};
            *(f32x4*)(p.out + (size_t)r * 1024 + i * 256 + lane * 4) = xa * ra * wv[i]; *(f32x4*)(p.out + (size_t)r2 * 1024 + i * 256 + lane * 4) = xb * rb * wv[i]; }
    }
}
__device__ void rope_pass(const Params& p) {
    unsigned char* ws = p.ws; bf16_t* HB = (bf16_t*)(ws + WS_HB); const float* __restrict__ COS = (const float*)(ws + WS_COS); const float* __restrict__ SIN = (const float*)(ws + WS_SIN);
    const size_t total = (size_t)12 * T_ * 4, stride = (size_t)gridDim.x * 512;
#pragma unroll 1
    for (size_t e0 = (size_t)blockIdx.x * 512 + opaque_tid(); e0 < total; e0 += 4 * stride) {
        u32x4 a[4], bq[4]; f32x4 c0[4], c1[4], s0[4], s1[4]; bf16_t* ptr[4]; float qs[4]; bool ok[4];
#pragma unroll
        for (int k = 0; k < 4; ++k) { const size_t e = e0 + k * stride; ok[k] = e < total; const size_t ee = ok[k] ? e : e0;
            const int ch = (int)(ee & 3); const size_t row = ee >> 2; const int hi = (int)(row >> 16), tokr = (int)(row & 65535);
            const int Hd = hi < 8 ? hi : hi + 4; qs[k] = hi < 8 ? 0.125f * LOG2E : 1.f;
            ptr[k] = HB + ((size_t)Hd * T_ + tokr) * 64 + ch * 8;
            a[k] = *(const u32x4*)ptr[k]; bq[k] = *(const u32x4*)(ptr[k] + 32);
            c0[k] = *(const f32x4*)(COS + (size_t)tokr * 32 + ch * 8); c1[k] = *(const f32x4*)(COS + (size_t)tokr * 32 + ch * 8 + 4);
            s0[k] = *(const f32x4*)(SIN + (size_t)tokr * 32 + ch * 8); s1[k] = *(const f32x4*)(SIN + (size_t)tokr * 32 + ch * 8 + 4); }
#pragma unroll
        for (int k = 0; k < 4; ++k) {
            const unsigned aw[4] = {a[k].x, a[k].y, a[k].z, a[k].w}, bw[4] = {bq[k].x, bq[k].y, bq[k].z, bq[k].w};
            const float cw8[8] = {c0[k][0], c0[k][1], c0[k][2], c0[k][3], c1[k][0], c1[k][1], c1[k][2], c1[k][3]}, sw8[8] = {s0[k][0], s0[k][1], s0[k][2], s0[k][3], s1[k][0], s1[k][1], s1[k][2], s1[k][3]};
            float o1[8], o2[8];
#pragma unroll
            for (int i = 0; i < 8; ++i) { const float x1 = bf2f((bf16_t)((aw[i >> 1] >> ((i & 1) * 16)) & 0xffff)), x2 = bf2f((bf16_t)((bw[i >> 1] >> ((i & 1) * 16)) & 0xffff));
                o1[i] = (x1 * cw8[i] - x2 * sw8[i]) * qs[k]; o2[i] = (x2 * cw8[i] + x1 * sw8[i]) * qs[k]; }
            u32x4 wa, wb; wa.x = cvt_pk_bf16(o1[0], o1[1]); wa.y = cvt_pk_bf16(o1[2], o1[3]); wa.z = cvt_pk_bf16(o1[4], o1[5]); wa.w = cvt_pk_bf16(o1[6], o1[7]);
            wb.x = cvt_pk_bf16(o2[0], o2[1]); wb.y = cvt_pk_bf16(o2[2], o2[3]); wb.z = cvt_pk_bf16(o2[4], o2[5]); wb.w = cvt_pk_bf16(o2[6], o2[7]);
            if (ok[k]) { *(u32x4*)ptr[k] = wa; *(u32x4*)(ptr[k] + 32) = wb; }
        }
    }
}
constexpr int NPHASE = 26;
template <int PH>
__device__ __forceinline__ void run_phase(const Params& p, unsigned char* lds) {
    unsigned char* ws = p.ws;
    const int G = gridDim.x, bid = blockIdx.x, tid = opaque_tid(), lane = tid & 63, wid = __builtin_amdgcn_readfirstlane(tid >> 6);
    const int gw = bid * 8 + wid, nw = G * 8;
    LAS unsigned char* ldsl = (LAS unsigned char*)lds;
    bf16_t* ACT = (bf16_t*)(ws + WS_ACT);
    constexpr int layer = PH >= 14 ? 1 : 0;
    float* SSQ = (float*)(ws + WS_SSQ);
#define GEMM_RUN(EPI, E, Aptr, Bptr, M_, N_, K_, lda_, rot) do { pg8::Gemm g_{(const bf16_t*)(Aptr), (const bf16_t*)(Bptr), (M_), (N_), (K_), (lda_)}; pg8::StaticOrder S_; S_.init((M_), (N_), G, (bid + (rot)) % G); \
        pg8::gemm_phase<EPI>(ldsl, g_, S_, E); } while (0)
    if constexpr (PH == 0) phase_prep(p, lds);
    else if constexpr (PH == 1) {
        { pg8::EpiInproj E{(bf16_t*)(ws + WS_HB), (float*)(ws + WS_SM)};
          GEMM_RUN(pg8::EpiInproj, E, ACT, ws + WS_WIN, T_, 3328, 1024, 1024, 0); }
        { pg8::EpiBf16 E{(bf16_t*)(ws + WS_VT), T_, 1.f, 0, nullptr}; GEMM_RUN(pg8::EpiBf16, E, ws + WS_WVT, ACT, 256, T_, 1024, 1024, 0); }
        for (int l = 0; l < 2; ++l) {
            { pg8::EpiBf16 E{(bf16_t*)(ws + WS_KMEM) + (size_t)l * 4096 * 512, 512, 1.f, 0, nullptr}; GEMM_RUN(pg8::EpiBf16, E, ws + WS_MEMN, (bf16_t*)(ws + WS_WKM) + (size_t)l * 512 * 1024, 4096, 512, 1024, 1024, 64 * l); }
            { pg8::EpiBf16 E{(bf16_t*)(ws + WS_VMT) + (size_t)l * 512 * 4096, 4096, 1.f, 0, nullptr}; GEMM_RUN(pg8::EpiBf16, E, (bf16_t*)(ws + WS_WVM) + (size_t)l * 512 * 1024, ws + WS_MEMN, 512, 4096, 1024, 1024, 64 * l + 32); }
        }
    } else if constexpr (PH == 2) {
        { pg8::EpiCmp1 E{(bf16_t*)(ws + WS_HID), (const float*)(ws + WS_BIAS1)};
          GEMM_RUN(pg8::EpiCmp1, E, (bf16_t*)(ws + WS_HB) + (size_t)8 * 16 * SQ * 64, ws + WS_WCMP1, 16384, 256, 2048, 1024, 0); }
        gdn_g1(p, (gw + 64 * 8) % nw, nw, lane);
        rope_pass(p);
    } else if constexpr (PH == 3) {
        cmp_stage2(p, lds);
        LAS float* Aw = (LAS float*)(ldsl + wid * 16640);
        for (int cid = gw; cid < 8192; cid += nw) gdn_g2(p, Aw, cid, lane);
    } else if constexpr (PH == 4) {
    } else if constexpr (PH == 5) {
        for (int e = bid * 512 + tid; e < 6 * T_; e += G * 512) SSQ[e] = 0.f;
        if (bid < 128) gdn_chain(p, lds, bid);
        unsigned* ctr = (unsigned*)(ws + WS_CTL);
        LAS int* s_item = (LAS int*)(ldsl + LDS_BYTES - 16);
        for (;;) {
            if (tid == 0) *s_item = (int)atomicAdd(ctr, 1u);
            __syncthreads();
            const int item = __builtin_amdgcn_readfirstlane(*s_item);
            __syncthreads();
            if (item >= 4096) break;
            nsa_item(p, lds, item);
        }
    } else if constexpr (PH == 6) { pg8::EpiResid<false> E{p.in[0], 1024, (bf16_t*)(ws + WS_ACT2), SSQ}; GEMM_RUN(pg8::EpiResid<false>, E, ACT, ws + WS_WOUT, T_, 1024, 1024, 1024, 0); }
    else if constexpr (PH == 8 || PH == 19) { pg8::EpiBf16 E{(bf16_t*)(ws + WS_QX), 512, 0.08838834764831845f * LOG2E, 0, SSQ + (size_t)(layer ? 3 : 0) * T_}; GEMM_RUN(pg8::EpiBf16, E, ws + WS_ACT2, (bf16_t*)(ws + WS_WQ) + (size_t)layer * 512 * 1024, T_, 512, 1024, 1024, 0); }
    else if constexpr (PH == 9 || PH == 20) { for (int blk = bid; blk < 256; blk += G) xattn_block(p, lds, blk, layer); }
    else if constexpr (PH == 10 || PH == 21) { pg8::EpiResid<true> E{ws + WS_ACT2, 1024, ACT, SSQ + (size_t)(layer ? 4 : 1) * T_}; GEMM_RUN(pg8::EpiResid<true>, E, ws + WS_OX, (bf16_t*)(ws + WS_WO) + (size_t)layer * 1024 * 512, T_, 1024, 512, 512, 0); }
    else if constexpr (PH == 12 || PH == 23) { pg8::EpiBf16 E{(bf16_t*)(ws + WS_H1), 4096, 1.f, 1, SSQ + (size_t)(layer ? 4 : 1) * T_}; GEMM_RUN(pg8::EpiBf16, E, ACT, (bf16_t*)(ws + WS_W1) + (size_t)layer * 4096 * 1024, T_, 4096, 1024, 1024, 0); }
    else if constexpr (PH == 13) { pg8::EpiResid<true> E{ACT, 1024, (bf16_t*)(ws + WS_ACT2), SSQ + (size_t)2 * T_}; GEMM_RUN(pg8::EpiResid<true>, E, ws + WS_H1, (bf16_t*)(ws + WS_W2), T_, 1024, 4096, 4096, 0); }
    else if constexpr (PH == 24) { pg8::EpiResid<true> E{ACT, 1024, (bf16_t*)(ws + WS_ACT2), SSQ + (size_t)5 * T_}; GEMM_RUN(pg8::EpiResid<true>, E, ws + WS_H1, (bf16_t*)(ws + WS_W2) + (size_t)1024 * 4096, T_, 1024, 4096, 4096, 0); }
    else if constexpr (PH == 15) { pg8::EpiBf16 E{(bf16_t*)(ws + WS_SC), 3072, 1.f, 0, SSQ + (size_t)2 * T_}; GEMM_RUN(pg8::EpiBf16, E, ws + WS_ACT2, ws + WS_WSCIN, T_, 3072, 1024, 1024, 0); }
    else if constexpr (PH == 16) sc_conv(p);
    else if constexpr (PH == 17) { pg8::EpiResid<true> E{ws + WS_ACT2, 1024, (bf16_t*)(ws + WS_ACT2), SSQ + (size_t)3 * T_}; GEMM_RUN(pg8::EpiResid<true>, E, ACT, ws + WS_WSCOUT, T_, 1024, 1024, 1024, 0); }
    else if constexpr (PH == 25) final_norm(p);
#undef GEMM_RUN
}

#ifndef SINGLE_LAUNCH
#define SINGLE_LAUNCH 1
#endif
template <int PH>
__global__ void __launch_bounds__(512, 2) phase_kernel(Params p) {
    extern __shared__ __attribute__((aligned(16))) unsigned char lds[];
    run_phase<PH>(p, lds);
}

#define XB_TMO      128
#define XB_XCNT(j)  (256  + 64 * (j))
#define XB_XSUB(j)  (1280 + 64 * (j))
#define XB_XGEN(j)  (2304 + 64 * (j))
#define XB_TOP      3328
#define XB_TOPGEN   3392
#define XCD_BAR_WORDS 3456
#define XB_SPIN_CAP (1u << 18)
__device__ __forceinline__ unsigned xb_ld(unsigned* p)              { return __hip_atomic_load(p, __ATOMIC_RELAXED, __HIP_MEMORY_SCOPE_AGENT); }
__device__ __forceinline__ unsigned xb_add(unsigned* p, unsigned v) { return __hip_atomic_fetch_add(p, v, __ATOMIC_RELAXED, __HIP_MEMORY_SCOPE_AGENT); }
__device__ __forceinline__ unsigned xb_xcc_id() { return (unsigned)__builtin_amdgcn_s_getreg((3 << 11) | 20) & 0xFu; }
#define XB_SPIN(cond, bar) do { while (cond) { __builtin_amdgcn_s_sleep(1); } } while (0)
struct XcdBarrier { unsigned* bar; unsigned x; volatile LAS unsigned* st; };
__device__ __forceinline__ XcdBarrier xcd_barrier_post(unsigned* bar, volatile LAS unsigned* st) {
    XcdBarrier b; b.bar = bar; b.x = xb_xcc_id(); b.st = st;
    if (threadIdx.x == 0) (void)xb_add(&bar[XB_XCNT(b.x)], 1u);
    return b;
}
__device__ __forceinline__ void xcd_barrier_complete(unsigned* bar, unsigned x, unsigned& nloc, unsigned& nx) {
    const unsigned G = gridDim.x * gridDim.y * gridDim.z;
    unsigned sum, cnt, mine, sp = 0u;
    for (;;) {
        sum = 0u; cnt = 0u; mine = 0u;
#pragma unroll
        for (unsigned j = 0; j < 16; ++j) { const unsigned c = xb_ld(&bar[XB_XCNT(j)]); sum += c; cnt += (c > 0u) ? 1u : 0u; mine = (j == x) ? c : mine; }
        if (sum == G) break;
        __builtin_amdgcn_s_sleep(1);
        if ((++sp & 255u) == 0u) { if (xb_ld(&bar[XB_TMO])) break; if (sp > XB_SPIN_CAP) { atomicAdd(&bar[XB_TMO], 1u); break; } }
    }
    nloc = mine > 0u ? mine : 1u; nx = cnt > 0u ? cnt : 1u;
}
__device__ __forceinline__ void xcd_barrier(unsigned* bar_, volatile LAS unsigned* st_) {
    XcdBarrier b; b.bar = bar_; b.x = xb_xcc_id(); b.st = st_;
    asm volatile("s_waitcnt vmcnt(0)" ::: "memory");
    __syncthreads();
    if (threadIdx.x == 0) {
        unsigned* bar = b.bar;
        __builtin_amdgcn_s_waitcnt(0);
        unsigned nloc = b.st[0], nx = b.st[1];
        const unsigned old = xb_add(&bar[XB_XSUB(b.x)], 1u);
        const unsigned gen = old / nloc;
        if (old + 1u == (gen + 1u) * nloc) {
            __builtin_amdgcn_fence(__ATOMIC_RELEASE, "agent");
            asm volatile("s_waitcnt vmcnt(0)" ::: "memory");
            const unsigned og = xb_add(&bar[XB_TOP], 1u);
            const unsigned tg = og / nx;
            if (og + 1u == (tg + 1u) * nx) xb_add(&bar[XB_TOPGEN], 1u);
            else XB_SPIN(xb_ld(&bar[XB_TOPGEN]) == tg, bar);
            __builtin_amdgcn_fence(__ATOMIC_ACQUIRE, "agent");
            xb_add(&bar[XB_XGEN(b.x)], 1u);
            asm volatile("s_waitcnt vmcnt(0)" ::: "memory");
        } else {
            XB_SPIN(xb_ld(&bar[XB_XGEN(b.x)]) == gen, bar);
            __builtin_amdgcn_fence(__ATOMIC_ACQUIRE, "agent");
            asm volatile("s_waitcnt vmcnt(0)" ::: "memory");
        }
    }
    __syncthreads();
}
constexpr size_t WS_XBAR = 65536;

template <int LO, int HI>
__device__ __forceinline__ void run_range(const Params& p, unsigned char* lds, cg::grid_group& grid) {
    run_phase<LO>(p, lds);
    if constexpr (LO < HI) { grid.sync(); run_range<LO + 1, HI>(p, lds, grid); }
}
template <int PH>
__device__ __forceinline__ void run_all(const Params& p, unsigned char* lds, cg::grid_group& grid) {
    asm volatile("; PHASE_MARK %0" :: "n"(PH));
    run_phase<PH>(p, lds);
#ifdef PROBE_SYNCS
    if constexpr (PH == 0) { for (int q = 0; q < PROBE_SYNCS; ++q) grid.sync(); }
#endif
#ifdef PROBE_SET
    if constexpr (((PROBE_SET >> PH) & 1u) != 0u) { grid.sync(); run_phase<PH>(p, lds); }
#endif
#ifdef PROBE_LO
    if constexpr (PH == PROBE_HI) { grid.sync(); if (blockIdx.x == 0 && opaque_tid() == 0) ((unsigned*)(p.ws + WS_CTL))[0] = 0u; grid.sync(); run_range<PROBE_LO, PROBE_HI>(p, lds, grid); }
#endif
    if constexpr (PH + 1 < NPHASE) { if constexpr (PH == 0) grid.sync(); else if constexpr (PH != 4 && PH != 7 && PH != 11 && PH != 14 && PH != 18 && PH != 22) xcd_barrier((unsigned*)(p.ws + WS_XBAR), (volatile LAS unsigned*)((LAS unsigned char*)lds + LDS_BYTES - 32)); run_all<PH + 1>(p, lds, grid); }
}
__global__ void __launch_bounds__(512, 2) hybrid_fwd(Params p) {
    extern __shared__ __attribute__((aligned(16))) unsigned char lds[];
    cg::grid_group grid = cg::this_grid();
    volatile LAS unsigned* st = (volatile LAS unsigned*)((LAS unsigned char*)lds + LDS_BYTES - 32);
    if (threadIdx.x < 2) st[threadIdx.x] = 0u;
    __syncthreads();
    { const XcdBarrier b0 = xcd_barrier_post((unsigned*)(p.ws + WS_XBAR), st);
      if (threadIdx.x == 0) { unsigned nloc, nx; xcd_barrier_complete(b0.bar, b0.x, nloc, nx); st[0] = nloc; st[1] = nx; }
      __syncthreads(); }
    run_all<0>(p, lds, grid);
}
template <int PH> static void launch_phases(const Params& p, int grid, hipStream_t stream) {
    static bool attr_done = false;
    if (!attr_done) { (void)hipFuncSetAttribute((const void*)phase_kernel<PH>, hipFuncAttributeMaxDynamicSharedMemorySize, LDS_BYTES); attr_done = true; }
    hipLaunchKernelGGL(phase_kernel<PH>, dim3(grid), dim3(512), LDS_BYTES, stream, p);
    if constexpr (PH + 1 < NPHASE) launch_phases<PH + 1>(p, grid, stream);
}

extern "C" void kernel_launch(void* const* d_in, const int* in_sizes, int n_in, void* d_out, int out_size, void* d_ws, size_t ws_size, hipStream_t stream) {
    static int grid = 0;
    if (grid == 0) {
        if (n_in != 28 || ws_size < WS_END) { fprintf(stderr, "kernel_launch: unexpected n_in %d or ws_size %zu (need %zu)\n", n_in, ws_size, (size_t)WS_END); grid = -1; return; }
        int dev = 0, cus = 0;
        (void)hipGetDevice(&dev); (void)hipDeviceGetAttribute(&cus, hipDeviceAttributeMultiprocessorCount, dev);
        grid = cus;
    }
    if (grid < 0) return;
    Params p{};
    for (int i = 0; i < 28; ++i) p.in[i] = (const float*)d_in[i];
    p.out = (float*)d_out; p.ws = (unsigned char*)d_ws; p.ph_lo = 0; p.ph_hi = NPHASE;
#if SINGLE_LAUNCH
    static bool attr_done = false;
    if (!attr_done) { if (hipFuncSetAttribute((const void*)hybrid_fwd, hipFuncAttributeMaxDynamicSharedMemorySize, LDS_BYTES) != hipSuccess) fprintf(stderr, "kernel_launch: hipFuncSetAttribute failed\n"); attr_done = true; }
    (void)hipMemsetAsync((char*)d_ws + WS_XBAR, 0, 16384, stream);
    void* args[] = {&p};
    hipError_t e = hipLaunchCooperativeKernel((const void*)hybrid_fwd, dim3(grid), dim3(512), args, LDS_BYTES, stream);
    if (e != hipSuccess) fprintf(stderr, "cooperative launch failed: %s (grid %d)\n", hipGetErrorString(e), grid);
#else
    launch_phases<0>(p, grid, stream);
#endif
}
```
